# Optimizing an MI355X kernel written in HIP

```python
import math
import jax, jax.numpy as jnp
from jax import lax
import numpy as np

D_MODEL = 1024
BATCH = 8
SEQ = 4096
DEPTH = 4

N_MEM = 256
D_FF = 2816

DA_HEADS = 4
DA_HEAD_DIM = 64
DA_V_DIM = 2 * DA_HEAD_DIM
DA_QK_WIDTH = DA_HEADS * 2 * DA_HEAD_DIM
DA_WIDTH = DA_HEADS * DA_V_DIM

POOL_WINDOWS = (2, 4, 8, 16)
POOL_GROUPS = 4
POOL_WIDTH = 256
POOL_GROUP_DIM = POOL_WIDTH // POOL_GROUPS

CONV_WIDTH = 256
CONV_KERNEL = 31

XA_HEADS = 4
XA_HEAD_DIM = 64
XA_WIDTH = XA_HEADS * XA_HEAD_DIM

N_BRANCH = 3
Q_BLOCK = 128
EPS = 1e-6
NEG_INF = -1e30

IN_SPLITS = (DA_QK_WIDTH, DA_QK_WIDTH, DA_WIDTH, POOL_WIDTH, 2 * CONV_WIDTH, N_BRANCH * D_MODEL)
IN_COLS = DA_QK_WIDTH * 2 + DA_WIDTH + POOL_WIDTH + 2 * CONV_WIDTH + N_BRANCH * D_MODEL

kernel_name = 'hybrid_gated_diffattn_pool_conv_macaron'


def rmsnorm(x, g):
    xf = x.astype(jnp.float32)
    y = xf * lax.rsqrt(jnp.mean(xf * xf, axis=-1, keepdims=True) + EPS)
    return (y * g.astype(jnp.float32)).astype(x.dtype)


def layernorm(x, g, b):
    xf = x.astype(jnp.float32)
    mu = jnp.mean(xf, axis=-1, keepdims=True)
    xc = xf - mu
    y = xc * lax.rsqrt(jnp.mean(xc * xc, axis=-1, keepdims=True) + EPS)
    return (y * g.astype(jnp.float32) + b.astype(jnp.float32)).astype(x.dtype)


def swiglu_half_step(x, norm_g, w_gu, w_down):
    h = rmsnorm(x, norm_g)
    gate, up = jnp.split(h @ w_gu, 2, axis=-1)
    return x + 0.5 * ((jax.nn.silu(gate) * up) @ w_down)


def split_cols(z):
    idx, acc = [], 0
    for w in IN_SPLITS[:-1]:
        acc += w
        idx.append(acc)
    return jnp.split(z, idx, axis=-1)


def diff_attention(q, k, v, lam, lam_init, subln_g):
    b, s = q.shape[0], q.shape[1]
    nblk = s // Q_BLOCK
    qb = jnp.moveaxis(q.reshape(b, nblk, Q_BLOCK, DA_HEADS, 2, DA_HEAD_DIM), 1, 0)
    kpos = jnp.arange(s)

    def one_block(args):
        i, qi = args
        scores = jnp.einsum('bqhcd,bkhcd->bhcqk', qi, k).astype(jnp.float32)
        qpos = i * Q_BLOCK + jnp.arange(Q_BLOCK)
        causal = kpos[None, :] <= qpos[:, None]
        p = jax.nn.softmax(jnp.where(causal, scores, NEG_INF), axis=-1)
        a = p[:, :, 0] - lam * p[:, :, 1]
        return jnp.einsum('bhqk,bkhe->bqhe', a.astype(v.dtype), v)

    o = lax.map(one_block, (jnp.arange(nblk), qb))
    o = jnp.moveaxis(o, 0, 1).reshape(b, s, DA_HEADS, DA_V_DIM)
    o = rmsnorm(o, subln_g) * (1.0 - lam_init)
    return o.reshape(b, s, DA_WIDTH)


def pool_mixer(u, w_group, scale):
    b, s, _ = u.shape
    uf = u.astype(jnp.float32).reshape(b, s, POOL_GROUPS, POOL_GROUP_DIM)
    c = jnp.cumsum(uf, axis=1)
    c_pad = jnp.pad(c, ((0, 0), (1, 0), (0, 0), (0, 0)))
    pos1 = jnp.arange(1, s + 1, dtype=jnp.float32)
    outs = []
    for g, w in enumerate(POOL_WINDOWS):
        cg = c_pad[:, :, g]
        lag = jnp.pad(cg, ((0, 0), (w, 0), (0, 0)))[:, 1:s + 1]
        win_sum = cg[:, 1:] - lag
        cnt = jnp.minimum(pos1, float(w))
        outs.append(win_sum / cnt[None, :, None] - uf[:, :, g])
    p = jnp.stack(outs, axis=2).astype(u.dtype)
    y = jnp.einsum('bsgc,gcd->bsgd', p, w_group).reshape(b, s, POOL_WIDTH)
    return y * scale


def conv_module(u, dw_w, dw_b, ln_g, ln_b):
    a, gate = jnp.split(u, 2, axis=-1)
    z = a * jax.nn.sigmoid(gate)
    z = lax.conv_general_dilated(
        z, dw_w[:, None, :], window_strides=(1,), padding=[(CONV_KERNEL - 1, 0)],
        dimension_numbers=('NWC', 'WIO', 'NWC'), feature_group_count=CONV_WIDTH) + dw_b
    z = layernorm(z, ln_g, ln_b)
    return jax.nn.silu(z)


def cross_attention_step(x, mem, norm_g, mem_norm_g, w_q, w_kv, q_g, k_g, w_o):
    b, s, _ = x.shape
    m_len = mem.shape[1]
    h = rmsnorm(x, norm_g)
    m = rmsnorm(mem, mem_norm_g)
    q = rmsnorm((h @ w_q).reshape(b, s, XA_HEADS, XA_HEAD_DIM), q_g) * (XA_HEAD_DIM ** -0.5)
    k, v = jnp.split(m @ w_kv, 2, axis=-1)
    k = rmsnorm(k.reshape(b, m_len, XA_HEADS, XA_HEAD_DIM), k_g)
    v = v.reshape(b, m_len, XA_HEADS, XA_HEAD_DIM)
    p = jax.nn.softmax(jnp.einsum('bqhd,bkhd->bhqk', q, k).astype(jnp.float32), axis=-1)
    o = jnp.einsum('bhqk,bkhd->bqhd', p.astype(v.dtype), v).reshape(b, s, XA_WIDTH)
    return x + o @ w_o


def setup_inputs(seed: int = 0) -> dict:
    key = jax.random.key(seed)
    ks = jax.random.split(key, 40)
    L, D = DEPTH, D_MODEL
    f32 = jnp.float32

    def w(k, shape, fan_in):
        return jax.random.normal(k, shape, f32) * (fan_in ** -0.5)

    def gain(k, shape):
        return 1.0 + 0.02 * jax.random.normal(k, shape, f32)

    def bias(k, shape):
        return 0.02 * jax.random.normal(k, shape, f32)

    return {
        'x': jax.random.normal(ks[0], (BATCH, SEQ, D), f32),
        'mem': jax.random.normal(ks[1], (BATCH, N_MEM, D), f32),
        'ffn1_norm': gain(ks[2], (L, D)),
        'ffn1_w_gu': w(ks[3], (L, D, 2 * D_FF), D),
        'ffn1_w_down': w(ks[4], (L, D_FF, D), D_FF),
        'mix_norm': gain(ks[5], (L, D)),
        'w_in': w(ks[6], (L, D, IN_COLS), D),
        'b_gate': bias(ks[7], (L, N_BRANCH * D)),
        'da_q_norm': gain(ks[8], (L, DA_HEAD_DIM)),
        'da_k_norm': gain(ks[9], (L, DA_HEAD_DIM)),
        'da_lambda': 0.1 * jax.random.normal(ks[10], (L, 4, DA_HEAD_DIM), f32),
        'da_subln': gain(ks[11], (L, DA_V_DIM)),
        'w_proj_attn': w(ks[12], (L, DA_WIDTH, D), DA_WIDTH),
        'pool_w': w(ks[13], (L, POOL_GROUPS, POOL_GROUP_DIM, POOL_GROUP_DIM), POOL_GROUP_DIM),
        'pool_scale': gain(ks[14], (L, POOL_WIDTH)),
        'w_proj_pool': w(ks[15], (L, POOL_WIDTH, D), POOL_WIDTH),
        'conv_dw': w(ks[16], (L, CONV_KERNEL, CONV_WIDTH), CONV_KERNEL),
        'conv_db': bias(ks[17], (L, CONV_WIDTH)),
        'conv_ln_g': gain(ks[18], (L, CONV_WIDTH)),
        'conv_ln_b': bias(ks[19], (L, CONV_WIDTH)),
        'w_proj_conv': w(ks[20], (L, CONV_WIDTH, D), CONV_WIDTH),
        'w_out': w(ks[21], (L, D, D), D),
        'xa_norm': gain(ks[22], (L, D)),
        'xa_mem_norm': gain(ks[23], (L, D)),
        'xa_w_q': w(ks[24], (L, D, XA_WIDTH), D),
        'xa_w_kv': w(ks[25], (L, D, 2 * XA_WIDTH), D),
        'xa_q_norm': gain(ks[26], (L, XA_HEAD_DIM)),
        'xa_k_norm': gain(ks[27], (L, XA_HEAD_DIM)),
        'xa_w_o': w(ks[28], (L, XA_WIDTH, D), XA_WIDTH),
        'ffn2_norm': gain(ks[29], (L, D)),
        'ffn2_w_gu': w(ks[30], (L, D, 2 * D_FF), D),
        'ffn2_w_down': w(ks[31], (L, D_FF, D), D_FF),
    }


def reference(x, mem, ffn1_norm, ffn1_w_gu, ffn1_w_down, mix_norm, w_in, b_gate,
              da_q_norm, da_k_norm, da_lambda, da_subln, w_proj_attn,
              pool_w, pool_scale, w_proj_pool,
              conv_dw, conv_db, conv_ln_g, conv_ln_b, w_proj_conv,
              w_out, xa_norm, xa_mem_norm, xa_w_q, xa_w_kv, xa_q_norm, xa_k_norm, xa_w_o,
              ffn2_norm, ffn2_w_gu, ffn2_w_down):
    b, s, _ = x.shape
    for l in range(DEPTH):
        x = swiglu_half_step(x, ffn1_norm[l], ffn1_w_gu[l], ffn1_w_down[l])

        h = rmsnorm(x, mix_norm[l])
        zq, zk, zv, zp, zc, zg = split_cols(h @ w_in[l])

        q = rmsnorm(zq.reshape(b, s, DA_HEADS, 2, DA_HEAD_DIM), da_q_norm[l]) * (DA_HEAD_DIM ** -0.5)
        k = rmsnorm(zk.reshape(b, s, DA_HEADS, 2, DA_HEAD_DIM), da_k_norm[l])
        v = zv.reshape(b, s, DA_HEADS, DA_V_DIM)
        lam_init = 0.8 - 0.6 * math.exp(-0.3 * l)
        lq = da_lambda[l].astype(jnp.float32)
        lam = jnp.exp(jnp.sum(lq[0] * lq[1])) - jnp.exp(jnp.sum(lq[2] * lq[3])) + lam_init
        y_a = diff_attention(q, k, v, lam, lam_init, da_subln[l]) @ w_proj_attn[l]

        y_b = pool_mixer(zp, pool_w[l], pool_scale[l]) @ w_proj_pool[l]

        y_c = conv_module(zc, conv_dw[l], conv_db[l], conv_ln_g[l], conv_ln_b[l]) @ w_proj_conv[l]

        gates = jax.nn.sigmoid((zg + b_gate[l]).astype(jnp.float32)).astype(x.dtype)
        gates = gates.reshape(b, s, N_BRANCH, D_MODEL)
        merged = gates[:, :, 0] * y_a + gates[:, :, 1] * y_b + gates[:, :, 2] * y_c
        x = x + merged @ w_out[l]

        x = cross_attention_step(x, mem, xa_norm[l], xa_mem_norm[l], xa_w_q[l], xa_w_kv[l],
                                 xa_q_norm[l], xa_k_norm[l], xa_w_o[l])

        x = swiglu_half_step(x, ffn2_norm[l], ffn2_w_gu[l], ffn2_w_down[l])
    return x
```

```cpp
#include <hip/hip_runtime.h>
#include <hip/hip_cooperative_groups.h>
#include <hip/hip_bf16.h>
#include <cstdio>
#include <cstdint>
#include <cmath>
namespace cg = cooperative_groups;
#ifndef MK_MASK
#define MK_MASK 0xFFFFFFFF
#endif
#define EN(k) ((MASK >> (k)) & 1u)
#ifndef MK_N_LAUNCHES
#define MK_N_LAUNCHES 1
#endif
namespace pg8 {
#define PG8_LAS __attribute__((address_space(3)))
typedef unsigned short bf16_t;
typedef short bf16x8 __attribute__((ext_vector_type(8)));
typedef float f32x4 __attribute__((ext_vector_type(4)));
typedef unsigned u32x4 __attribute__((ext_vector_type(4)));
constexpr int BM = 256, BK = 64, HALF = 128, HTB = HALF * BK * 2  , STAGE_BYTES = 8 * HTB, NXCD = 8, WGM = 8;

__host__ __device__ __forceinline__ int lds_byte(int r, int c) { const int st = (r >> 4) * 2 + (c >> 5), rr = r & 15, cc = c & 31, ob = rr * 64 + cc * 2; return st * 1024 + (ob ^ (((ob >> 9) & 1) << 5)); }
__host__ __device__ __forceinline__ void stage_rc(int b, int& R, int& C) { const int st = b / 1024, sb = b % 1024, swz = sb ^ (((sb >> 9) & 1) << 5); R = (st >> 1) * 16 + swz / 64; C = (st & 1) * 32 + (swz % 64) / 2; }
__host__ __device__ __forceinline__ int perm32(int rho) { const int n = rho >> 4, i = rho & 15; return 8 * (i >> 2) + 4 * n + (i & 3); }

struct Unit { int pm, pn, koff, nt, seg; };
struct Gemm { const bf16_t* A; const bf16_t* Bt; int lda, ldb; };

struct StaticOrder {
    int nM, nN, nwg, G, c;
    __host__ __device__ void init(int M, int N, int G_, int c_) { nM = M / BM; nN = N / BM; nwg = nM * nN; G = G_; c = c_; }
    __host__ __device__ bool next(int i, Unit& u) const {
        const long L = (long)i * G + c; if (L >= nwg) return false;
        int wgid = (int)L; { const int q = nwg / NXCD, r = nwg % NXCD, xcd = wgid % NXCD, off = wgid / NXCD; wgid = (xcd < r ? xcd * (q + 1) : r * (q + 1) + (xcd - r) * q) + off; }
        const int nig = WGM * nN, gid = wgid / nig, fm = gid * WGM, gsz = (nM - fm) < WGM ? (nM - fm) : WGM;
        u.pm = fm + ((wgid % nig) % gsz); u.pn = (wgid % nig) / gsz; return true;
    }
    __device__ __forceinline__ void a_ready(const Unit&) const {}
    __device__ __forceinline__ void done(const Unit&) const {}
};

typedef float f32x2 __attribute__((ext_vector_type(2)));
typedef unsigned u32x2 __attribute__((ext_vector_type(2)));
constexpr float NEPS = 1e-6f;
constexpr float QC2 = 0.125f * 1.4426950408889634f;
__device__ __forceinline__ unsigned cvt_pk_bf16(float lo, float hi) { unsigned r; asm volatile("v_cvt_pk_bf16_f32 %0, %1, %2" : "=v"(r) : "v"(lo), "v"(hi)); return r; }
__device__ __forceinline__ float sigm(float v) { return __builtin_amdgcn_rcpf(1.f + __builtin_amdgcn_exp2f(-1.4426950408889634f * v)); }
__device__ __forceinline__ u32x4 pack8(const f32x4 a, const f32x4 b) { u32x4 w; w.x = cvt_pk_bf16(a[0], a[1]); w.y = cvt_pk_bf16(a[2], a[3]); w.z = cvt_pk_bf16(b[0], b[1]); w.w = cvt_pk_bf16(b[2], b[3]); return w; }
__device__ __forceinline__ void unpack8(const u32x4 w, f32x4& a, f32x4& b) {
    a[0] = __uint_as_float(w.x << 16); a[1] = __uint_as_float(w.x & 0xffff0000u); a[2] = __uint_as_float(w.y << 16); a[3] = __uint_as_float(w.y & 0xffff0000u);
    b[0] = __uint_as_float(w.z << 16); b[1] = __uint_as_float(w.z & 0xffff0000u); b[2] = __uint_as_float(w.w << 16); b[3] = __uint_as_float(w.w & 0xffff0000u); }
__device__ __forceinline__ float row_rstd(const float* SS, int row, int fq) {
    const f32x4 p = *(const f32x4*)(SS + (size_t)row * 16 + 4 * fq);
    float s = (p[0] + p[1]) + (p[2] + p[3]);
    s += __shfl_xor(s, 16); s += __shfl_xor(s, 32);
    return rsqrtf(s * (1.0f / 1024.0f) + NEPS);
}
__device__ __forceinline__ void rows_rstd(const float* SS, int row0, int fq, float (&rs)[2][4]) {
    f32x4 p[2][4];
#pragma unroll
    for (int ai = 0; ai < 2; ++ai)
#pragma unroll
        for (int m = 0; m < 4; ++m) p[ai][m] = *(const f32x4*)(SS + (size_t)(row0 + ai * 128 + m * 16) * 16 + 4 * fq);
#pragma unroll
    for (int ai = 0; ai < 2; ++ai)
#pragma unroll
        for (int m = 0; m < 4; ++m) { float t = (p[ai][m][0] + p[ai][m][1]) + (p[ai][m][2] + p[ai][m][3]);
            t += __shfl_xor(t, 16); t += __shfl_xor(t, 32); rs[ai][m] = rsqrtf(t * (1.0f / 1024.0f) + NEPS); }
}
__device__ __forceinline__ float dot4(const f32x4 a) { return (a[0] * a[0] + a[1] * a[1]) + (a[2] * a[2] + a[3] * a[3]); }
typedef f32x4 acc_t[2][2][4][2];

struct EpiSwiglu {
    static constexpr bool PERM = true, AFTER_DRAIN = false; __device__ __forceinline__ bool keep(const Unit&) const { return false; }
    bf16_t* H; const float* SS;
    __device__ __forceinline__ void operator()(const acc_t& acc, const Unit& u, int wr, int wc, int fr, int fq) const {
        const int row0 = u.pm * BM + wr * 64 + fr, col = u.pn * 128 + wc * 32 + 8 * fq;
        float rsv[2][4]; rows_rstd(SS, row0, fq, rsv);
#pragma unroll
        for (int ai = 0; ai < 2; ++ai)
#pragma unroll
            for (int m = 0; m < 4; ++m) { const int row = row0 + ai * HALF + m * 16; const float rs = rsv[ai][m];
                f32x4 h[2];
#pragma unroll
                for (int n = 0; n < 2; ++n) { const f32x4 g = acc[ai][0][m][n] * rs, up = acc[ai][1][m][n] * rs;
#pragma unroll
                    for (int i = 0; i < 4; ++i) h[n][i] = g[i] * sigm(g[i]) * up[i]; }
                *(u32x4*)(H + (size_t)row * 2816 + col) = pack8(h[0], h[1]); }
    }
};
struct EpiResid {
    static constexpr bool PERM = true, AFTER_DRAIN = false; __device__ __forceinline__ bool keep(const Unit&) const { return false; }
    bf16_t* XB; bf16_t* XL; float* SS; float alpha;
    __device__ __forceinline__ void operator()(const acc_t& acc, const Unit& u, int wr, int wc, int fr, int fq) const {
        const int row0 = u.pm * BM + wr * 64 + fr, col0 = u.pn * BM + wc * 32 + 8 * fq;
        u32x4 hwa[2][4][2];
#pragma unroll
        for (int ai = 0; ai < 2; ++ai)
#pragma unroll
            for (int m = 0; m < 4; ++m)
#pragma unroll
                for (int bj = 0; bj < 2; ++bj) hwa[ai][m][bj] = *(const u32x4*)(XB + (size_t)(row0 + ai * HALF + m * 16) * 1024 + col0 + bj * HALF);
#pragma unroll
        for (int ai = 0; ai < 2; ++ai) {
#pragma unroll
            for (int m = 0; m < 4; ++m) { const int row = row0 + ai * HALF + m * 16; float ss = 0.f;
#pragma unroll
                for (int bj = 0; bj < 2; ++bj) { const size_t c = (size_t)row * 1024 + col0 + bj * HALF;
                    f32x4 h0, h1; unpack8(hwa[ai][m][bj], h0, h1);
                    const f32x4 o0 = h0 + acc[ai][bj][m][0] * alpha, o1 = h1 + acc[ai][bj][m][1] * alpha;
                    *(u32x4*)(XB + c) = pack8(o0, o1);
                    ss += dot4(o0) + dot4(o1); }
                ss += __shfl_xor(ss, 16); ss += __shfl_xor(ss, 32);
                if (fq == 0) SS[(size_t)row * 16 + u.pn * 4 + wc] = ss; }
            asm volatile("" ::: "memory"); }
    }
};
struct EpiResidF32 {
    static constexpr bool PERM = true, AFTER_DRAIN = false; __device__ __forceinline__ bool keep(const Unit&) const { return false; }
    bf16_t* XB; float* outf; float alpha;
    __device__ __forceinline__ void operator()(const acc_t& acc, const Unit& u, int wr, int wc, int fr, int fq) const {
        const int row0 = u.pm * BM + wr * 64 + fr, col0 = u.pn * BM + wc * 32 + 8 * fq;
        u32x4 hwa[2][4][2];
#pragma unroll
        for (int ai = 0; ai < 2; ++ai)
#pragma unroll
            for (int m = 0; m < 4; ++m)
#pragma unroll
                for (int bj = 0; bj < 2; ++bj) hwa[ai][m][bj] = *(const u32x4*)(XB + (size_t)(row0 + ai * HALF + m * 16) * 1024 + col0 + bj * HALF);
#pragma unroll
        for (int ai = 0; ai < 2; ++ai) {
#pragma unroll
            for (int m = 0; m < 4; ++m) { const int row = row0 + ai * HALF + m * 16; float ss = 0.f;
#pragma unroll
                for (int bj = 0; bj < 2; ++bj) { const size_t c = (size_t)row * 1024 + col0 + bj * HALF;
                    f32x4 h0, h1; unpack8(hwa[ai][m][bj], h0, h1);
                    const f32x4 o0 = h0 + acc[ai][bj][m][0] * alpha, o1 = h1 + acc[ai][bj][m][1] * alpha;
                    *(f32x4*)(outf + c) = o0; *(f32x4*)(outf + c + 4) = o1;
                    (void)ss; } }
            asm volatile("" ::: "memory"); }
    }
};
struct EpiWin {
    static constexpr bool PERM = true, AFTER_DRAIN = false; __device__ __forceinline__ bool keep(const Unit&) const { return false; }
    const float* SS; bf16_t *zq, *zk, *zv, *zp, *zc, *G; const float *gq, *gk, *bgate;
    __device__ __forceinline__ void operator()(const acc_t& acc, const Unit& u, int wr, int wc, int fr, int fq) const {
        const int pn = u.pn, row0 = u.pm * BM + wr * 64 + fr;
        float rsv[2][4]; rows_rstd(SS, row0, fq, rsv);
        if (pn < 4) {
            bf16_t* dst = pn < 2 ? zq : zk; int oz = 0; asm volatile("" : "+v"(oz)); const float* gp = (pn < 2 ? gq : gk) + 8 * fq + oz; const float sc = pn < 2 ? QC2 : 1.f; const int cb = (pn & 1) * 256 + wc * 64 + 8 * fq;
            f32x4 gv[2][2];
#pragma unroll
            for (int bj = 0; bj < 2; ++bj)
#pragma unroll
                for (int n = 0; n < 2; ++n) gv[bj][n] = *(const f32x4*)(gp + 32 * bj + 4 * n);
#pragma unroll
            for (int ai = 0; ai < 2; ++ai)
#pragma unroll
                for (int m = 0; m < 4; ++m) { const int row = row0 + ai * HALF + m * 16; const float rs = rsv[ai][m];
                    f32x4 v[2][2]; float ss = 0.f;
#pragma unroll
                    for (int bj = 0; bj < 2; ++bj)
#pragma unroll
                        for (int n = 0; n < 2; ++n) { v[bj][n] = acc[ai][bj][m][n] * rs; ss += dot4(v[bj][n]); }
                    ss += __shfl_xor(ss, 16); ss += __shfl_xor(ss, 32);
                    const float r2 = rsqrtf(ss * (1.0f / 64.0f) + NEPS) * sc;
#pragma unroll
                    for (int bj = 0; bj < 2; ++bj) *(u32x4*)(dst + (size_t)row * 512 + cb + 32 * bj) = pack8(v[bj][0] * gv[bj][0] * r2, v[bj][1] * gv[bj][1] * r2); }
        } else if (pn < 7) {
            bf16_t* dst = pn < 6 ? zv : zp; const int ld = pn < 6 ? 512 : 256, cb = (pn == 5 ? 256 : 0) + wc * 32 + 8 * fq;
#pragma unroll
            for (int ai = 0; ai < 2; ++ai)
#pragma unroll
                for (int m = 0; m < 4; ++m) { const int row = row0 + ai * HALF + m * 16; const float rs = rsv[ai][m];
#pragma unroll
                    for (int bj = 0; bj < 2; ++bj) *(u32x4*)(dst + (size_t)row * ld + cb + HALF * bj) = pack8(acc[ai][bj][m][0] * rs, acc[ai][bj][m][1] * rs); }
        } else if (pn < 9) {
            const int cb = (pn - 7) * 128 + wc * 32 + 8 * fq;
#pragma unroll
            for (int ai = 0; ai < 2; ++ai)
#pragma unroll
                for (int m = 0; m < 4; ++m) { const int row = row0 + ai * HALF + m * 16; const float rs = rsv[ai][m];
                    f32x4 h[2];
#pragma unroll
                    for (int n = 0; n < 2; ++n) { const f32x4 a = acc[ai][0][m][n] * rs, g = acc[ai][1][m][n] * rs;
#pragma unroll
                        for (int i = 0; i < 4; ++i) h[n][i] = a[i] * sigm(g[i]); }
                    *(u32x4*)(zc + (size_t)row * 256 + cb) = pack8(h[0], h[1]); }
        } else {
            const int cb = (pn - 9) * 256 + wc * 32 + 8 * fq;
#pragma unroll
            for (int ai = 0; ai < 2; ++ai)
#pragma unroll
                for (int m = 0; m < 4; ++m) { const int row = row0 + ai * HALF + m * 16; const float rs = rsv[ai][m];
#pragma unroll
                    for (int bj = 0; bj < 2; ++bj) *(u32x4*)(G + (size_t)row * 3072 + cb + HALF * bj) = pack8(acc[ai][bj][m][0] * rs, acc[ai][bj][m][1] * rs); }
        }
    }
};
struct EpiMerged {
    static constexpr bool PERM = true;  static constexpr bool AFTER_DRAIN = false;
    const bf16_t* G; bf16_t* Mg; const float* bg;
    __device__ __forceinline__ bool keep(const Unit& u) const { return u.seg < 2; }
    __device__ __forceinline__ void operator()(acc_t& acc, const Unit& u, int wr, int wc, int fr, int fq) const {
        const int row0 = u.pm * BM + wr * 64 + fr, cb = u.pn * BM + wc * 32 + 8 * fq, seg = u.seg;
        int oz = 0; asm volatile("" : "+v"(oz));
        constexpr float NL2E = -1.4426950408889634f;
        if (seg < 2) {
            f32x4 ba[2][2], bn[2][2];
#pragma unroll
            for (int bj = 0; bj < 2; ++bj)
#pragma unroll
                for (int n = 0; n < 2; ++n) { ba[bj][n] = *(const f32x4*)(bg + seg * 1024 + cb + oz + HALF * bj + 4 * n); bn[bj][n] = *(const f32x4*)(bg + (seg + 1) * 1024 + cb + oz + HALF * bj + 4 * n); }
#pragma unroll
            for (int ai = 0; ai < 2; ++ai)
#pragma unroll
                for (int mp = 0; mp < 2; ++mp) {
                    u32x4 ga[2][2], gn[2][2];
#pragma unroll
                    for (int mm = 0; mm < 2; ++mm)
#pragma unroll
                        for (int bj = 0; bj < 2; ++bj) { const bf16_t* gp = G + (size_t)(row0 + ai * HALF + (2 * mp + mm) * 16) * 3072 + seg * 1024 + cb + HALF * bj;
                            ga[mm][bj] = *(const u32x4*)gp; gn[mm][bj] = *(const u32x4*)(gp + 1024); }
#pragma unroll
                    for (int mm = 0; mm < 2; ++mm)
#pragma unroll
                        for (int bj = 0; bj < 2; ++bj) { const int m = 2 * mp + mm; f32x4 a0, a1, n0, n1; unpack8(ga[mm][bj], a0, a1); unpack8(gn[mm][bj], n0, n1);
#pragma unroll
                            for (int i = 0; i < 4; ++i) {
                                const float r0 = (1.f + __builtin_amdgcn_exp2f(NL2E * (n0[i] + bn[bj][0][i]))) * __builtin_amdgcn_rcpf(1.f + __builtin_amdgcn_exp2f(NL2E * (a0[i] + ba[bj][0][i])));
                                const float r1 = (1.f + __builtin_amdgcn_exp2f(NL2E * (n1[i] + bn[bj][1][i]))) * __builtin_amdgcn_rcpf(1.f + __builtin_amdgcn_exp2f(NL2E * (a1[i] + ba[bj][1][i])));
                                acc[ai][bj][m][0][i] *= r0; acc[ai][bj][m][1][i] *= r1; } }
                    asm volatile("" ::: "memory"); }
        } else {
            f32x4 ba[2][2];
#pragma unroll
            for (int bj = 0; bj < 2; ++bj)
#pragma unroll
                for (int n = 0; n < 2; ++n) ba[bj][n] = *(const f32x4*)(bg + 2048 + cb + oz + HALF * bj + 4 * n);
#pragma unroll
            for (int ai = 0; ai < 2; ++ai) {
                u32x4 ga[4][2];
#pragma unroll
                for (int m = 0; m < 4; ++m)
#pragma unroll
                    for (int bj = 0; bj < 2; ++bj) ga[m][bj] = *(const u32x4*)(G + (size_t)(row0 + ai * HALF + m * 16) * 3072 + 2048 + cb + HALF * bj);
#pragma unroll
                for (int m = 0; m < 4; ++m)
#pragma unroll
                    for (int bj = 0; bj < 2; ++bj) { f32x4 g0, g1; unpack8(ga[m][bj], g0, g1);
#pragma unroll
                        for (int i = 0; i < 4; ++i) { g0[i] = sigm(g0[i] + ba[bj][0][i]); g1[i] = sigm(g1[i] + ba[bj][1][i]); }
                        *(u32x4*)(Mg + (size_t)(row0 + ai * HALF + m * 16) * 1024 + cb + HALF * bj) = pack8(acc[ai][bj][m][0] * g0, acc[ai][bj][m][1] * g1); }
                asm volatile("" ::: "memory"); }
        }
    }
};
struct EpiXq {
    static constexpr bool PERM = true, AFTER_DRAIN = false; __device__ __forceinline__ bool keep(const Unit&) const { return false; }
    const float* SS; bf16_t* qx; const float* gq;
    __device__ __forceinline__ void operator()(const acc_t& acc, const Unit& u, int wr, int wc, int fr, int fq) const {
        const int row0 = u.pm * BM + wr * 64 + fr, cb = wc * 64 + 8 * fq; float rsv[2][4]; rows_rstd(SS, row0, fq, rsv); int oz = 0; asm volatile("" : "+v"(oz)); const float* gp = gq + 8 * fq + oz;
        f32x4 gv[2][2];
#pragma unroll
        for (int bj = 0; bj < 2; ++bj)
#pragma unroll
            for (int n = 0; n < 2; ++n) gv[bj][n] = *(const f32x4*)(gp + 32 * bj + 4 * n);
#pragma unroll
        for (int ai = 0; ai < 2; ++ai)
#pragma unroll
            for (int m = 0; m < 4; ++m) { const int row = row0 + ai * HALF + m * 16; const float rs = rsv[ai][m];
                f32x4 v[2][2]; float ss = 0.f;
#pragma unroll
                for (int bj = 0; bj < 2; ++bj)
#pragma unroll
                    for (int n = 0; n < 2; ++n) { v[bj][n] = acc[ai][bj][m][n] * rs; ss += dot4(v[bj][n]); }
                ss += __shfl_xor(ss, 16); ss += __shfl_xor(ss, 32);
                const float r2 = rsqrtf(ss * (1.0f / 64.0f) + NEPS) * QC2;
#pragma unroll
                for (int bj = 0; bj < 2; ++bj) *(u32x4*)(qx + (size_t)row * 256 + cb + 32 * bj) = pack8(v[bj][0] * gv[bj][0] * r2, v[bj][1] * gv[bj][1] * r2); }
    }
};
struct EpiMemKV {
    static constexpr bool PERM = true, AFTER_DRAIN = false; __device__ __forceinline__ bool keep(const Unit&) const { return false; }
    const float* SSM; bf16_t *KX, *VX; const float* gk;
    __device__ __forceinline__ void operator()(const acc_t& acc, const Unit& u, int wr, int wc, int fr, int fq) const {
        const int l = u.pn >> 1, row0 = u.pm * BM + wr * 64 + fr;
        float rsv[2][4]; rows_rstd(SSM, row0, fq, rsv);
        if ((u.pn & 1) == 0) {
            bf16_t* dst = KX + (size_t)l * 2048 * 256; int oz = 0; asm volatile("" : "+v"(oz)); const float* gp = gk + l * 64 + 8 * fq + oz; const int cb = wc * 64 + 8 * fq;
            f32x4 gv[2][2];
#pragma unroll
            for (int bj = 0; bj < 2; ++bj)
#pragma unroll
                for (int n = 0; n < 2; ++n) gv[bj][n] = *(const f32x4*)(gp + 32 * bj + 4 * n);
#pragma unroll
            for (int ai = 0; ai < 2; ++ai)
#pragma unroll
                for (int m = 0; m < 4; ++m) { const int row = row0 + ai * HALF + m * 16; const float rs = rsv[ai][m];
                    f32x4 v[2][2]; float ss = 0.f;
#pragma unroll
                    for (int bj = 0; bj < 2; ++bj)
#pragma unroll
                        for (int n = 0; n < 2; ++n) { v[bj][n] = acc[ai][bj][m][n] * rs; ss += dot4(v[bj][n]); }
                    ss += __shfl_xor(ss, 16); ss += __shfl_xor(ss, 32);
                    const float r2 = rsqrtf(ss * (1.0f / 64.0f) + NEPS);
#pragma unroll
                    for (int bj = 0; bj < 2; ++bj) *(u32x4*)(dst + (size_t)row * 256 + cb + 32 * bj) = pack8(v[bj][0] * gv[bj][0] * r2, v[bj][1] * gv[bj][1] * r2); }
        } else {
            bf16_t* dst = VX + (size_t)l * 2048 * 256; const int cb = wc * 32 + 8 * fq;
#pragma unroll
            for (int ai = 0; ai < 2; ++ai)
#pragma unroll
                for (int m = 0; m < 4; ++m) { const int row = row0 + ai * HALF + m * 16; const float rs = rsv[ai][m];
#pragma unroll
                    for (int bj = 0; bj < 2; ++bj) *(u32x4*)(dst + (size_t)row * 256 + cb + HALF * bj) = pack8(acc[ai][bj][m][0] * rs, acc[ai][bj][m][1] * rs); }
        }
    }
};
struct OrderStd {
    StaticOrder b; int nt;
    __device__ void init(int M, int N, int K, int G, int c) { b.init(M, N, G, c); nt = K / BK; }
    __device__ bool next(int i, Unit& u) const { if (!b.next(i, u)) return false; u.koff = 0; u.nt = nt; u.seg = 0; return true; }
    __device__ __forceinline__ void a_ready(const Unit&) const {}
    __device__ __forceinline__ void done(const Unit&) const {}
};
struct OrderSeg3 {
    StaticOrder b;
    __device__ void init(int M, int N, int G, int c) { b.init(M, N, G, c); }
    __device__ bool next(int i, Unit& u) const { const int t = i / 3, s = i - 3 * t; if (!b.next(t, u)) return false; u.seg = s; u.koff = s == 0 ? 0 : (s == 1 ? 512 : 768); u.nt = s == 0 ? 8 : 4; return true; }
    __device__ __forceinline__ void a_ready(const Unit&) const {}
    __device__ __forceinline__ void done(const Unit&) const {}
};
template <class Epi, class Sched, bool ALIGN_EPI = false, bool SP2 = false>
__device__ __forceinline__ void gemm_phase(PG8_LAS unsigned char* lds, const Gemm g, const Sched& S, const Epi& E, const int tid) {
    const int wid = __builtin_amdgcn_readfirstlane(tid >> 6), lane = tid & 63, wr = wid >> 2, wc = wid & 3, fr = lane & 15, fq = lane >> 4;
    unsigned voffA[2], voffB[2];
#pragma unroll
    for (int i = 0; i < 2; ++i) { int R, C; stage_rc(tid * 16 + i * 8192, R, C); const int Rb = Epi::PERM ? ((R & ~31) + perm32(R & 31)) : R;
        voffA[i] = (unsigned)(R * g.lda + C) * 2u; voffB[i] = (unsigned)(Rb * g.ldb + C) * 2u; }
    const size_t kstep = (size_t)(BK * 2);
    const size_t hstepA = (size_t)HALF * g.lda * 2, hstepB = (size_t)HALF * g.ldb * 2;
    const size_t tstepA = 2 * hstepA, tstepB = 2 * hstepB;
    const unsigned ldsw = (unsigned)wid * 1024u;
    const int aoff = lds_byte(wr * 64 + fr, fq * 8), boff = lds_byte(wc * 32 + fr, fq * 8);
#define PG8_SA(b, h) (((b) * 2 + (h)) * HTB)
#define PG8_SB(b, h) ((4 + (b) * 2 + (h)) * HTB)
#define PG8_STAGE(bufoff, gbase, voff) do { _Pragma("unroll") for (int _i = 0; _i < 2; ++_i) \
        __builtin_amdgcn_global_load_lds((const unsigned*)((const char*)(gbase) + (voff)[_i]), (PG8_LAS unsigned*)(lds + (bufoff) + ldsw + _i * 8192), 16, 0, 0); } while (0)
#define PG8_LDA(dst, b, h) do { _Pragma("unroll") for (int m = 0; m < 4; ++m) _Pragma("unroll") for (int k = 0; k < 2; ++k) dst[m][k] = *(const PG8_LAS bf16x8*)(lds + PG8_SA(b, h) + aoff + m * 2048 + k * 1024); } while (0)
#define PG8_LDB(dst, b, h) do { _Pragma("unroll") for (int n = 0; n < 2; ++n) _Pragma("unroll") for (int k = 0; k < 2; ++k) dst[n][k] = *(const PG8_LAS bf16x8*)(lds + PG8_SB(b, h) + boff + n * 2048 + k * 1024); } while (0)
#define PG8_MMA(ai, bj, At, Bt) do { __builtin_amdgcn_s_setprio(1); _Pragma("unroll") for (int m = 0; m < 4; ++m) _Pragma("unroll") for (int n = 0; n < 2; ++n) _Pragma("unroll") for (int k = 0; k < 2; ++k) \
        acc[ai][bj][m][n] = __builtin_amdgcn_mfma_f32_16x16x32_bf16(Bt[n][k], At[m][k], acc[ai][bj][m][n], 0, 0, 0); __builtin_amdgcn_s_setprio(0); } while (0)
#define PG8_WAIT_V(n) asm volatile("s_waitcnt vmcnt(" #n ")" ::: "memory")
#define PG8_WAIT_L(n) asm volatile("s_waitcnt lgkmcnt(" #n ")" ::: "memory")
#define PG8_BAR __builtin_amdgcn_s_barrier()
#define PG8_SCHED __builtin_amdgcn_sched_barrier(0)
    Unit cur, nxt; int ui = 0;
    if (!S.next(0, cur)) return;
    f32x4 acc[2][2][4][2];
#pragma unroll
    for (int a = 0; a < 2; ++a)
#pragma unroll
        for (int b = 0; b < 2; ++b)
#pragma unroll
            for (int m = 0; m < 4; ++m)
#pragma unroll
                for (int n = 0; n < 2; ++n) acc[a][b][m][n] = (f32x4){0.f, 0.f, 0.f, 0.f};
    bf16x8 At[4][2], B0[2][2], B1[2][2];
    const char* cA = (const char*)g.A + (size_t)cur.pm * tstepA + (size_t)cur.koff * 2; const char* cB = (const char*)g.Bt + (size_t)cur.pn * tstepB + (size_t)cur.koff * 2;
    S.a_ready(cur);
    if constexpr (SP2) {
        PG8_STAGE(PG8_SB(0, 0), cB, voffB); PG8_STAGE(PG8_SB(0, 1), cB + hstepB, voffB); PG8_STAGE(PG8_SA(0, 0), cA, voffA); PG8_STAGE(PG8_SA(0, 1), cA + hstepA, voffA);
        if (wr == 1) PG8_BAR;
        PG8_WAIT_V(2); PG8_BAR;
        PG8_STAGE(PG8_SB(1, 0), cB + kstep, voffB); PG8_STAGE(PG8_SA(1, 0), cA + kstep, voffA); PG8_STAGE(PG8_SB(1, 1), cB + hstepB + kstep, voffB);
        PG8_WAIT_V(6); PG8_BAR;
    } else {
        PG8_STAGE(PG8_SB(0, 0), cB, voffB); PG8_STAGE(PG8_SA(0, 0), cA, voffA); PG8_STAGE(PG8_SB(0, 1), cB + hstepB, voffB); PG8_STAGE(PG8_SA(0, 1), cA + hstepA, voffA);
        if (wr == 1) PG8_BAR;
        PG8_WAIT_V(4); PG8_BAR;
        PG8_STAGE(PG8_SB(1, 0), cB + kstep, voffB); PG8_STAGE(PG8_SA(1, 0), cA + kstep, voffA); PG8_STAGE(PG8_SB(1, 1), cB + hstepB + kstep, voffB);
        PG8_WAIT_V(6); PG8_BAR;
    }
    for (;;) {
        const bool has_next = S.next(ui + 1, nxt);
        const char* nA = has_next ? (const char*)g.A + (size_t)nxt.pm * tstepA + (size_t)nxt.koff * 2 : cA; const char* nB = has_next ? (const char*)g.Bt + (size_t)nxt.pn * tstepB + (size_t)nxt.koff * 2 : cB;
        const int nt = cur.nt;
        for (int t = 0; t < nt; t += 2) {
            const bool last = (t == nt - 2);
            const char* a1 = cA + (size_t)(t + 1) * kstep;
            const char* a2 = last ? nA : cA + (size_t)(t + 2) * kstep; const char* b2 = last ? nB : cB + (size_t)(t + 2) * kstep;
            const char* a3 = a2 + kstep; const char* b3 = b2 + kstep;
            if (last && has_next) S.a_ready(nxt);
            if constexpr (SP2) {
            PG8_LDB(B0, 0, 0); PG8_LDB(B1, 0, 1); PG8_SCHED; PG8_LDA(At, 0, 0); PG8_STAGE(PG8_SA(1, 1), a1 + hstepA, voffA);
            PG8_WAIT_V(8); PG8_WAIT_L(0); PG8_BAR; PG8_MMA(0, 0, At, B0); PG8_MMA(0, 1, At, B1); PG8_BAR; PG8_SCHED;
            PG8_LDA(At, 0, 1); PG8_STAGE(PG8_SB(0, 0), b2, voffB); PG8_STAGE(PG8_SB(0, 1), b2 + hstepB, voffB); PG8_STAGE(PG8_SA(0, 0), a2, voffA);
            PG8_WAIT_V(8); PG8_WAIT_L(0); PG8_BAR; PG8_MMA(1, 0, At, B0); PG8_MMA(1, 1, At, B1); PG8_BAR; PG8_SCHED;
            PG8_LDB(B0, 1, 0); PG8_LDB(B1, 1, 1); PG8_SCHED; PG8_LDA(At, 1, 0); PG8_STAGE(PG8_SA(0, 1), a2 + hstepA, voffA);
            PG8_WAIT_V(8); PG8_WAIT_L(0); PG8_BAR; PG8_MMA(0, 0, At, B0); PG8_MMA(0, 1, At, B1); PG8_BAR; PG8_SCHED;
            PG8_LDA(At, 1, 1); PG8_STAGE(PG8_SB(1, 0), b3, voffB); PG8_STAGE(PG8_SB(1, 1), b3 + hstepB, voffB); PG8_STAGE(PG8_SA(1, 0), a3, voffA);
            PG8_WAIT_V(8); PG8_WAIT_L(0); PG8_BAR; PG8_MMA(1, 0, At, B0); PG8_MMA(1, 1, At, B1); PG8_BAR; PG8_SCHED;
            } else {
            PG8_LDB(B0, 0, 0); PG8_SCHED; PG8_LDA(At, 0, 0); PG8_STAGE(PG8_SA(1, 1), a1 + hstepA, voffA);
            PG8_WAIT_L(8); PG8_BAR; PG8_WAIT_L(0); PG8_MMA(0, 0, At, B0); PG8_BAR; PG8_SCHED;
            PG8_LDB(B1, 0, 1); PG8_STAGE(PG8_SB(0, 0), b2, voffB);
            PG8_BAR; PG8_WAIT_L(0); PG8_MMA(0, 1, At, B1); PG8_BAR;
            PG8_LDA(At, 0, 1); PG8_STAGE(PG8_SA(0, 0), a2, voffA);
            PG8_BAR; PG8_WAIT_L(0); PG8_MMA(1, 0, At, B0); PG8_BAR; PG8_SCHED;
            PG8_STAGE(PG8_SB(0, 1), b2 + hstepB, voffB);
            PG8_WAIT_V(6); PG8_BAR; PG8_MMA(1, 1, At, B1); PG8_BAR;
            PG8_LDB(B0, 1, 0); PG8_SCHED; PG8_LDA(At, 1, 0); PG8_STAGE(PG8_SA(0, 1), a2 + hstepA, voffA);
            PG8_WAIT_L(8); PG8_BAR; PG8_WAIT_L(0); PG8_MMA(0, 0, At, B0); PG8_BAR; PG8_SCHED;
            PG8_LDB(B1, 1, 1); PG8_STAGE(PG8_SB(1, 0), b3, voffB);
            PG8_BAR; PG8_WAIT_L(0); PG8_MMA(0, 1, At, B1); PG8_BAR;
            PG8_LDA(At, 1, 1); PG8_STAGE(PG8_SA(1, 0), a3, voffA);
            PG8_BAR; PG8_WAIT_L(0); PG8_MMA(1, 0, At, B0); PG8_BAR; PG8_SCHED;
            PG8_STAGE(PG8_SB(1, 1), b3 + hstepB, voffB);
            PG8_WAIT_V(6); PG8_BAR; PG8_MMA(1, 1, At, B1); PG8_BAR;
            }
        }
        if constexpr (ALIGN_EPI) { if (wr == 0) PG8_BAR; }
        if constexpr (!Epi::AFTER_DRAIN) { E(acc, cur, wr, wc, fr, fq); S.done(cur); }
        if (!has_next) break;
        if (!E.keep(cur)) {
#pragma unroll
        for (int a = 0; a < 2; ++a)
#pragma unroll
            for (int b = 0; b < 2; ++b)
#pragma unroll
                for (int m = 0; m < 4; ++m)
#pragma unroll
                    for (int n = 0; n < 2; ++n) acc[a][b][m][n] = (f32x4){0.f, 0.f, 0.f, 0.f};
        }
        cur = nxt; cA = nA; cB = nB; ++ui;
        if constexpr (ALIGN_EPI) { if (wr == 1) PG8_BAR; }
    }
    PG8_WAIT_V(0);
    if constexpr (!ALIGN_EPI) { if (wr == 0) PG8_BAR; }
    PG8_BAR;
    if constexpr (Epi::AFTER_DRAIN) { E.fused(acc, cur, wr, wc, fr, fq, lds, wid, lane); S.done(cur); }
#undef PG8_SA
#undef PG8_SB
#undef PG8_STAGE
#undef PG8_LDA
#undef PG8_LDB
#undef PG8_MMA
#undef PG8_WAIT_V
#undef PG8_WAIT_L
#undef PG8_BAR
#undef PG8_SCHED
}
}
#include <hip/hip_bf16.h>
namespace attn_body {
using bf16=__hip_bfloat16;
using bf16x8=__attribute__((ext_vector_type(8)))short;
using s16x4=__attribute__((ext_vector_type(4)))short;
using f32x16=__attribute__((ext_vector_type(16)))float;
using u32x4=__attribute__((ext_vector_type(4)))unsigned;
constexpr int D=64;
constexpr int NW=8,QBLK=32,QB=QBLK*NW,KVBLK=64;
__device__ __forceinline__ int crow(int r,int hi){return (r&3)+8*(r>>2)+4*hi;}
#define SBAR() __builtin_amdgcn_sched_barrier(0)
__device__ __forceinline__ void cmask(f32x16&p0,f32x16&p1,int jb,int qrel,int hi){
  const float NEG=-INFINITY; int kb=64*jb+4*hi;
  #pragma unroll
  for(int r=0;r<16;++r){int kv=kb+(r&3)+8*(r>>2); if(kv>qrel)p0[r]=NEG; if(kv+32>qrel)p1[r]=NEG;}
}

constexpr int NSLOT=3, SLOTB=8192;
constexpr int LDS_K=0, LDS_V=NSLOT*SLOTB, LDS_WS=2*NSLOT*SLOTB, LDS_OST=LDS_WS+NW*64*4, LDS_BYTES=LDS_OST+NW*4096;
constexpr float C2=0.125f*1.4426950408889634f;
__device__ __forceinline__ void glds16(const void*gsrc,unsigned lds_dst){unsigned keep;
  asm volatile("s_mov_b32 %0, m0\n\ts_mov_b32 m0, %2\n\ts_nop 0\n\tglobal_load_lds_dwordx4 %1, off\n\ts_mov_b32 m0, %0":"=&s"(keep):"v"(gsrc),"s"(lds_dst):"memory");}
__device__ __forceinline__ float max3f(float a,float b,float c){float r;asm("v_max3_f32 %0, %1, %2, %3":"=v"(r):"v"(a),"v"(b),"v"(c));return r;}
__device__ __forceinline__ float max2f(float a,float b){float r;asm("v_max_f32_e32 %0, %1, %2":"=v"(r):"v"(a),"v"(b));return r;}
__device__ __forceinline__ float fadd_s(float a,float b){float r;asm("v_add_f32_e32 %0, %1, %2":"=v"(r):"v"(a),"v"(b));return r;}
__device__ __forceinline__ float fsub_s(float a,float b){float r;asm("v_sub_f32_e32 %0, %1, %2":"=v"(r):"v"(a),"v"(b));return r;}
typedef float f32x2_t __attribute__((ext_vector_type(2))); typedef __bf16 bf16x2_t __attribute__((ext_vector_type(2)));
__device__ __forceinline__ unsigned cvtpk_s(float lo,float hi){f32x2_t v={lo,hi};bf16x2_t b=__builtin_convertvector(v,bf16x2_t);return __builtin_bit_cast(unsigned,b);}
#define WAIT_BAR(N) asm volatile("s_waitcnt vmcnt(" #N ") lgkmcnt(0)\n\ts_barrier":::"memory")

__device__ __forceinline__ void qkt(f32x16&p0,f32x16&p1,const char*Kslot,const bf16x8*qr,const f32x16&negm,int r32,int hi){
  const char*kb=Kslot+hi*1024+r32*16;
  #pragma unroll
  for(int d0=0;d0<4;++d0){
    const bf16x8 b0=*reinterpret_cast<const bf16x8*>(kb+d0*2048);
    const bf16x8 b1=*reinterpret_cast<const bf16x8*>(kb+d0*2048+512);
    if(d0==0){p0=__builtin_amdgcn_mfma_f32_32x32x16_bf16(b0,qr[0],negm,0,0,0);p1=__builtin_amdgcn_mfma_f32_32x32x16_bf16(b1,qr[0],negm,0,0,0);}
    else{p0=__builtin_amdgcn_mfma_f32_32x32x16_bf16(b0,qr[d0],p0,0,0,0);p1=__builtin_amdgcn_mfma_f32_32x32x16_bf16(b1,qr[d0],p1,0,0,0);}}
}
typedef __attribute__((address_space(3))) const char* lds_cptr;
typedef short v4i16_t __attribute__((ext_vector_type(4)));
__device__ __forceinline__ void kload8(bf16x8*kf,lds_cptr kp){
  kf[0]=*(const __attribute__((address_space(3))) bf16x8*)(kp);      kf[1]=*(const __attribute__((address_space(3))) bf16x8*)(kp+512);
  kf[2]=*(const __attribute__((address_space(3))) bf16x8*)(kp+2048); kf[3]=*(const __attribute__((address_space(3))) bf16x8*)(kp+2560);
  kf[4]=*(const __attribute__((address_space(3))) bf16x8*)(kp+4096); kf[5]=*(const __attribute__((address_space(3))) bf16x8*)(kp+4608);
  kf[6]=*(const __attribute__((address_space(3))) bf16x8*)(kp+6144); kf[7]=*(const __attribute__((address_space(3))) bf16x8*)(kp+6656);
}
__device__ __forceinline__ void kload2(bf16x8*kf,lds_cptr kp,int j){ kf[2*j]=*(const __attribute__((address_space(3))) bf16x8*)(kp+j*2048); kf[2*j+1]=*(const __attribute__((address_space(3))) bf16x8*)(kp+j*2048+512); }
__device__ __forceinline__ s16x4 vtr(lds_cptr p){ return __builtin_bit_cast(s16x4,__builtin_amdgcn_ds_read_tr16_b64_v4i16((__attribute__((address_space(3))) v4i16_t*)p)); }
__device__ __forceinline__ float rowmax(const f32x16&p0,const f32x16&p1){
  float a=max3f(p0[0],p0[1],p1[0]),b=max3f(p0[2],p0[3],p1[1]);a=max3f(a,p1[2],p1[3]);
  #pragma unroll
  for(int r=4;r<16;r+=4){a=max3f(a,p0[r],p0[r+1]);b=max3f(b,p0[r+2],p0[r+3]);a=max3f(a,p1[r],p1[r+1]);b=max3f(b,p1[r+2],p1[r+3]);}
  const float m=max2f(a,b);
  auto rr=__builtin_amdgcn_permlane32_swap(__float_as_uint(m),__float_as_uint(m),false,false);
  return max2f(__uint_as_float(rr[0]),__uint_as_float(rr[1]));
}
__device__ __forceinline__ void pv(f32x16*o,int vb,bf16x8 pa0,bf16x8 pa1,bf16x8 pa2,bf16x8 pa3){
  #pragma unroll
  for(int d0=0;d0<2;++d0){s16x4 lo[4],hi[4];
    #pragma unroll
    for(int ks=0;ks<4;++ks){
      asm volatile("ds_read_b64_tr_b16 %0,%1 offset:%c2":"=&v"(lo[ks]):"v"(vb),"i"(d0*4096+ks*1024):"memory");
      asm volatile("ds_read_b64_tr_b16 %0,%1 offset:%c2":"=&v"(hi[ks]):"v"(vb),"i"(d0*4096+ks*1024+512):"memory");}
    asm volatile("s_waitcnt lgkmcnt(0)":::"memory");SBAR();
    #define PK(k) (bf16x8){lo[k][0],lo[k][1],lo[k][2],lo[k][3],hi[k][0],hi[k][1],hi[k][2],hi[k][3]}
    o[d0]=__builtin_amdgcn_mfma_f32_32x32x16_bf16(pa0,PK(0),o[d0],0,0,0);
    o[d0]=__builtin_amdgcn_mfma_f32_32x32x16_bf16(pa1,PK(1),o[d0],0,0,0);
    o[d0]=__builtin_amdgcn_mfma_f32_32x32x16_bf16(pa2,PK(2),o[d0],0,0,0);
    o[d0]=__builtin_amdgcn_mfma_f32_32x32x16_bf16(pa3,PK(3),o[d0],0,0,0);
    #undef PK
  }
}

#ifndef ATTN_STORE16
#define ATTN_STORE16(p,v) (*(u32x4*)(p)=(v))
#endif
template<int THRL,bool CAUSAL> __device__ __forceinline__ void attn_unit(const bf16*Qw0,const bf16*__restrict__ Kh,const bf16*__restrict__ Vh,bf16*Ow0,const int PQ,const int PK,const int PV,const int PO,const int NT,char*shm,const int tid){
  const int lane=tid&63,r32=lane&31,hi=lane>>5; const int wid=__builtin_amdgcn_readfirstlane(tid>>6);
  const bf16*Qw=Qw0+(long)(wid*QBLK)*PQ;
  const unsigned lds0=(unsigned)(uintptr_t)shm;
  float*wsf=(float*)(shm+LDS_WS)+wid*64;
  const bf16*ksrc=Kh+(long)lane*PK+wid*8;
  const bf16*vsrc=Vh+(long)(16*(wid&3)+(lane>>2))*PV+(wid>>2)*32+(lane&3)*8;
  const unsigned kdst=lds0+LDS_K+wid*1024, vdst=lds0+LDS_V+wid*1024;
  #define DMA_K(t,slot) glds16(ksrc+(long)(t)*KVBLK*PK,(unsigned)__builtin_amdgcn_readfirstlane(kdst+(slot)))
  #define DMA_V(t,slot) glds16(vsrc+(long)(t)*KVBLK*PV,(unsigned)__builtin_amdgcn_readfirstlane(vdst+(slot)))
  const int vb0=(int)(lds0+LDS_V)+((lane>>4)&1)*32+(lane&3)*8+(4*hi+((lane&15)>>2))*64;
  const char*Kbase=shm+LDS_K; bf16x8 kf[8];
  const lds_cptr shm3=(lds_cptr)shm; const lds_cptr kp0=shm3+LDS_K+hi*1024+r32*16; const lds_cptr vp0=shm3+LDS_V+((lane>>4)&1)*32+(lane&3)*8+(4*hi+((lane&15)>>2))*64;
  DMA_K(0,0);DMA_V(0,0);DMA_K(1,SLOTB);
  bf16x8 qr[4];
  #pragma unroll
  for(int d0=0;d0<4;++d0)qr[d0]=*reinterpret_cast<const bf16x8*>(&Qw[(long)r32*PQ+d0*16+hi*8]);
  const __attribute__((address_space(3))) char* qst=(const __attribute__((address_space(3))) char*)shm3+LDS_OST+wid*4096+lane*16;
  #pragma unroll
  for(int d0=0;d0<4;++d0)*(__attribute__((address_space(3))) bf16x8*)((__attribute__((address_space(3))) char*)shm3+LDS_OST+wid*4096+lane*16+d0*1024)=qr[d0];
  #define QRL(d) (*(const __attribute__((address_space(3))) bf16x8*)(qst+(d)*1024))
  float mhat=0.f,l_reg=0.f;f32x16 o[2];o[0]=f32x16{};o[1]=f32x16{};
  const int qrel=wid*QBLK+r32;
  #define CMASK(P0,P1,t) do{ if(CAUSAL){int jb_=(t)-(NT-4); if(jb_>=0)cmask(P0,P1,jb_,qrel,hi);} }while(0)
  bool resc=false;
  #define START(P0,P1) do{ const float rm=rowmax(P0,P1); resc=false; \
    { const float dl=rm; mhat=fadd_s(mhat,dl); \
      _Pragma("unroll") for(int r=0;r<16;++r){P0[r]=fsub_s(P0[r],dl);P1[r]=fsub_s(P1[r],dl);} \
      } \
    _Pragma("unroll") for(int r=0;r<16;++r)P0[r]=__builtin_amdgcn_exp2f(P0[r]); }while(0)
  #define RESC() do{ if(resc){ asm volatile("s_waitcnt lgkmcnt(0)":::"memory"); \
      _Pragma("unroll") for(int d_=0;d_<2;++d_) _Pragma("unroll") for(int r=0;r<16;++r)o[d_][r]*=wsf[crow(r,hi)]; } }while(0)
  f32x16 pA0,pA1,pB0,pB1;
  int sl_prev=0,sl_cur=0,sl_next=SLOTB;
  #define ROT() do{sl_prev=sl_cur;sl_cur=sl_next;sl_next=(sl_next==(NSLOT-1)*SLOTB)?0:sl_next+SLOTB;}while(0)
  DMA_K(2,2*SLOTB);
  WAIT_BAR(3);
  qkt(pA0,pA1,Kbase,qr,f32x16{},r32,hi);asm volatile("s_nop 15\n\ts_nop 7":"+v"(pA0),"+v"(pA1));CMASK(pA0,pA1,0);
  START(pA0,pA1);
  _Pragma("unroll") for(int r=0;r<16;++r)pA1[r]=__builtin_amdgcn_exp2f(pA1[r]);
  WAIT_BAR(0);
  DMA_K(3,0);DMA_V(1,SLOTB);
  ROT();
  kload8(kf,kp0+sl_cur);
  WAIT_BAR(2);
  s16x4 vlo[8],vhi[8]; u32x4 pw0,pw1,pw2,pw3;
  #define PKW(P,B) cvtpk_s(P[B],P[B+1])
  #define PAF(k) __builtin_bit_cast(bf16x8,pw##k)
  #define VFR(i) (bf16x8){vlo[i][0],vlo[i][1],vlo[i][2],vlo[i][3],vhi[i][0],vhi[i][1],vhi[i][2],vhi[i][3]}
  #define PIN(x) asm volatile("":"+v"(x))
  #define MX3(a,b,c) __builtin_fmaxf(__builtin_fmaxf((a),(b)),(c))
  #define GAPA(MF,A0,A1,A2,A3,W0,W1,PW) do{ MF; sacc+=A0; sacc+=A1; sacc+=A2; sacc+=A3; PIN(sacc); W0; W1; PIN(PW); SBAR(); }while(0)
  #define EX(v) __builtin_amdgcn_exp2f(v)
  #define GAPB(MF,X,B) do{ MF; X[B]=EX(X[B]); X[B+1]=EX(X[B+1]); X[B+2]=EX(X[B+2]); X[B+3]=EX(X[B+3]); PIN(X); SBAR(); }while(0)
  #define VRD(i) do{ vlo[i]=vtr(vp_+(((i)>>2)*4096+((i)&3)*1024)); vhi[i]=vtr(vp_+(((i)>>2)*4096+((i)&3)*1024+512)); }while(0)
  #define KRD(G,j) do{ if(G){ kload2(kf,kp0+sl_next,j); SBAR(); } }while(0)
  #define STEP(C0,C1,P0,P1,t,GK,GV,GL) do{ SBAR(); \
    const lds_cptr vp_=vp0+sl_prev; \
    VRD(0); SBAR(); float sacc=(P0[0]+P0[1]); \
    GAPA(C0=__builtin_amdgcn_mfma_f32_32x32x16_bf16(kf[0],QRL(0),f32x16{},0,0,0), P0[2],P0[3],P0[4],P0[5],     pw0[0]=PKW(P0,0), pw0[1]=PKW(P0,2), pw0); \
    VRD(4); SBAR(); GAPA(C1=__builtin_amdgcn_mfma_f32_32x32x16_bf16(kf[1],QRL(0),f32x16{},0,0,0), P0[6],P0[7],P0[8],P0[9],     pw0[2]=PKW(P0,4), pw0[3]=PKW(P0,6), pw0); \
    VRD(1); SBAR(); GAPA(C0=__builtin_amdgcn_mfma_f32_32x32x16_bf16(kf[2],QRL(1),C0,0,0,0),   P0[10],P0[11],P0[12],P0[13], pw1[0]=PKW(P0,8), pw1[1]=PKW(P0,10), pw1); \
    VRD(5); SBAR(); GAPA(C1=__builtin_amdgcn_mfma_f32_32x32x16_bf16(kf[3],QRL(1),C1,0,0,0),   P0[14],P0[15],P1[0],P1[1],   pw1[2]=PKW(P0,12),pw1[3]=PKW(P0,14), pw1); \
    VRD(2); SBAR(); GAPA(C0=__builtin_amdgcn_mfma_f32_32x32x16_bf16(kf[4],QRL(2),C0,0,0,0),   P1[2],P1[3],P1[4],P1[5],     pw2[0]=PKW(P1,0), pw2[1]=PKW(P1,2), pw2); \
    VRD(6); SBAR(); GAPA(C1=__builtin_amdgcn_mfma_f32_32x32x16_bf16(kf[5],QRL(2),C1,0,0,0),   P1[6],P1[7],P1[8],P1[9],     pw2[2]=PKW(P1,4), pw2[3]=PKW(P1,6), pw2); \
    VRD(3); SBAR(); GAPA(C0=__builtin_amdgcn_mfma_f32_32x32x16_bf16(kf[6],QRL(3),C0,0,0,0),   P1[10],P1[11],P1[12],P1[13], pw3[0]=PKW(P1,8), pw3[1]=PKW(P1,10), pw3); \
    VRD(7); SBAR(); GAPA(C1=__builtin_amdgcn_mfma_f32_32x32x16_bf16(kf[7],QRL(3),C1,0,0,0),   P1[14],P1[15],0.f,0.f,       pw3[2]=PKW(P1,12),pw3[3]=PKW(P1,14), pw3); \
    l_reg+=sacc; \
    if(GK){DMA_K((t)+3,sl_cur);} if(GV){DMA_V((t)+1,sl_next);} \
    { const float mh_=mhat; _Pragma("unroll") for(int r=0;r<16;++r){C0[r]-=mh_;C1[r]-=mh_;} } \
    CMASK(C0,C1,t); \
    { float a=MX3(C0[0],C0[1],C1[0]),b=MX3(C0[2],C0[3],C1[1]); a=MX3(a,C1[2],C1[3]); \
      _Pragma("unroll") for(int r=4;r<16;r+=4){a=MX3(a,C0[r],C0[r+1]);b=MX3(b,C0[r+2],C0[r+3]);a=MX3(a,C1[r],C1[r+1]);b=MX3(b,C1[r+2],C1[r+3]);} \
      float rm=__builtin_fmaxf(a,b); { auto rr=__builtin_amdgcn_permlane32_swap(__float_as_uint(rm),__float_as_uint(rm),false,false); rm=__builtin_fmaxf(__uint_as_float(rr[0]),__uint_as_float(rr[1])); } \
      resc=false; \
      if(__builtin_expect(__any(rm>(float)THRL),0)){ const float dl=__builtin_fmaxf(rm,0.f); mhat+=dl; \
        _Pragma("unroll") for(int r=0;r<16;++r){C0[r]-=dl;C1[r]-=dl;} \
        const float f=__builtin_amdgcn_exp2f(-dl); l_reg*=f; if(hi==0)wsf[r32]=f; resc=true; } } \
    SBAR(); \
    GAPB(o[0]=__builtin_amdgcn_mfma_f32_32x32x16_bf16(PAF(0),VFR(0),o[0],0,0,0), C0,0); \
    GAPB(o[1]=__builtin_amdgcn_mfma_f32_32x32x16_bf16(PAF(0),VFR(4),o[1],0,0,0), C0,4); \
    KRD(GL,0); GAPB(o[0]=__builtin_amdgcn_mfma_f32_32x32x16_bf16(PAF(1),VFR(1),o[0],0,0,0), C0,8); \
    KRD(GL,1); GAPB(o[1]=__builtin_amdgcn_mfma_f32_32x32x16_bf16(PAF(1),VFR(5),o[1],0,0,0), C0,12); \
    KRD(GL,2); GAPB(o[0]=__builtin_amdgcn_mfma_f32_32x32x16_bf16(PAF(2),VFR(2),o[0],0,0,0), C1,0); \
    KRD(GL,3); GAPB(o[1]=__builtin_amdgcn_mfma_f32_32x32x16_bf16(PAF(2),VFR(6),o[1],0,0,0), C1,4); \
    GAPB(o[0]=__builtin_amdgcn_mfma_f32_32x32x16_bf16(PAF(3),VFR(3),o[0],0,0,0), C1,8); \
    GAPB(o[1]=__builtin_amdgcn_mfma_f32_32x32x16_bf16(PAF(3),VFR(7),o[1],0,0,0), C1,12); \
    }while(0)
  int t=1;
  #undef CMASK
  #define CMASK(P0,P1,t) do{}while(0)
  for(;t+5<NT;t+=2){
    STEP(pB0,pB1,pA0,pA1,t,true,true,true);     WAIT_BAR(2); RESC(); ROT();
    STEP(pA0,pA1,pB0,pB1,t+1,true,true,true);   WAIT_BAR(2); RESC(); ROT();
  }
  #undef CMASK
  #define CMASK(P0,P1,t) do{ if(CAUSAL){int jb_=(t)-(NT-4); if(jb_>=0)cmask(P0,P1,jb_,qrel,hi);} }while(0)
  #define ENDW(tt) do{ if((tt)+3<NT){WAIT_BAR(2);} else if((tt)+2<NT){WAIT_BAR(1);} else {WAIT_BAR(0);} }while(0)
  for(;t+1<NT;t+=2){
    STEP(pB0,pB1,pA0,pA1,t,(t+3<NT),(t+1<NT),(t+1<NT));       ENDW(t);   RESC(); ROT();
    STEP(pA0,pA1,pB0,pB1,t+1,(t+4<NT),(t+2<NT),(t+2<NT));     ENDW(t+1); RESC(); ROT();
  }
  STEP(pB0,pB1,pA0,pA1,NT-1,false,false,false); RESC();
  { float sacc=pB0[0]+pB0[1]; _Pragma("unroll") for(int r=2;r<16;++r)sacc+=pB0[r]; _Pragma("unroll") for(int r=0;r<16;++r)sacc+=pB1[r]; l_reg+=sacc;
    pw0=(u32x4){PKW(pB0,0),PKW(pB0,2),PKW(pB0,4),PKW(pB0,6)};pw1=(u32x4){PKW(pB0,8),PKW(pB0,10),PKW(pB0,12),PKW(pB0,14)};pw2=(u32x4){PKW(pB1,0),PKW(pB1,2),PKW(pB1,4),PKW(pB1,6)};pw3=(u32x4){PKW(pB1,8),PKW(pB1,10),PKW(pB1,12),PKW(pB1,14)};
    SBAR(); pv(o,vb0+sl_cur,PAF(0),PAF(1),PAF(2),PAF(3)); }
  #undef PKW
  #undef PAF
  #undef VFR
  #undef PIN
  #undef MX3
  #undef GAPA
  #undef GAPB
  #undef EX
  #undef VRD
  #undef KRD
  #undef STEP
  #undef ENDW
  {auto rr=__builtin_amdgcn_permlane32_swap(__float_as_uint(l_reg),__float_as_uint(l_reg),false,false);l_reg=__uint_as_float(rr[0])+__uint_as_float(rr[1]);}
  if(hi==0)wsf[32+r32]=l_reg;asm volatile("s_waitcnt lgkmcnt(0)":::"memory");
  float rli[16];
  #pragma unroll
  for(int r=0;r<16;++r)rli[r]=__builtin_amdgcn_rcpf(wsf[32+crow(r,hi)]);
  bf16*Ow=Ow0+(long)(wid*QBLK)*PO;
  { bf16*stg=(bf16*)(shm+LDS_OST)+wid*2048;
    #pragma unroll
    for(int r=0;r<16;++r){const int orow=crow(r,hi);
      #pragma unroll
      for(int d0=0;d0<2;++d0)stg[orow*64+d0*32+r32]=__float2bfloat16(o[d0][r]*rli[r]);}
    asm volatile("s_waitcnt lgkmcnt(0)":::"memory");
    #pragma unroll
    for(int i=0;i<4;++i){const int row=i*8+(lane>>3),ch=lane&7; const u32x4 v=*(const u32x4*)(stg+row*64+ch*8); ATTN_STORE16(Ow+(long)row*PO+ch*8,v);} }
  asm volatile("s_waitcnt lgkmcnt(0)\n\ts_barrier":::"memory");
  #undef DMA_K
  #undef DMA_V
  #undef CMASK
  #undef START
  #undef RESC
  #undef ROT
}
constexpr int ATTN_LDS_BYTES=LDS_BYTES;
#undef SBAR
#undef WAIT_BAR
}
constexpr int NWAVES = 8;
constexpr int DEPTH = 4, DM = 1024, SEQ = 4096, NB = 8, TOK = NB * SEQ, DFF = 2816, NMEM = 256, MEMROWS = NB * NMEM, INCOLS = 5376;
constexpr size_t MiB = 1u << 20;
constexpr size_t WS_SS = 1 * MiB, WS_SSM = 3 * MiB, WS_MEMB = 4 * MiB, WS_KX = 8 * MiB, WS_VX = 12 * MiB, WS_WKV = 16 * MiB;
constexpr size_t WS_WB = 20 * MiB;
constexpr size_t WB_GU1 = 0, WB_D1 = WB_GU1 + (size_t)2 * DFF * DM * 2, WB_IN = WB_D1 + (size_t)DM * DFF * 2, WB_PABC = WB_IN + (size_t)INCOLS * DM * 2,
                 WB_OUT = WB_PABC + (size_t)DM * DM * 2, WB_XQ = WB_OUT + (size_t)DM * DM * 2, WB_XO = WB_XQ + (size_t)256 * DM * 2, WB_GU2 = WB_XO + (size_t)DM * 256 * 2,
                 WB_D2 = WB_GU2 + (size_t)2 * DFF * DM * 2, WB_END = WB_D2 + (size_t)DM * DFF * 2;
static_assert(WB_END <= 50 * MiB, "weights");
constexpr size_t WS_XB = 70 * MiB;
constexpr size_t WS_Z = 134 * MiB;
constexpr size_t WS_ZQ = WS_Z, WS_ZK = WS_Z + 32 * MiB, WS_ZV = WS_Z + 64 * MiB, WS_ZP = WS_Z + 96 * MiB, WS_ZC = WS_Z + 112 * MiB, WS_G = WS_Z + 128 * MiB;
constexpr size_t WS_H = WS_Z;
constexpr size_t WS_OABC = WS_Z, WS_MG = WS_Z + 64 * MiB;
constexpr size_t WS_QX = WS_Z, WS_OX = WS_Z + 16 * MiB;
constexpr size_t WS_XL = WS_G + (size_t)TOK * 3072 * 2;
constexpr size_t WS_END = WS_XL + (size_t)TOK * 1024 * 2;
static_assert(WS_H + (size_t)TOK * DFF * 2 <= WS_XL && WS_END <= 520 * MiB, "ws map");
constexpr int LDS_TOTAL = 147456;

#define GAS __attribute__((address_space(1)))
#define LAS __attribute__((address_space(3)))
typedef unsigned short bf16;
typedef unsigned v4u __attribute__((ext_vector_type(4)));
typedef float f32x4 __attribute__((ext_vector_type(4)));
#define LDS_WAIT() asm volatile("s_waitcnt lgkmcnt(0)" ::: "memory")
__device__ __forceinline__ unsigned pk2(float lo, float hi) { return pg8::cvt_pk_bf16(lo, hi); }
__device__ __forceinline__ float bf2f(unsigned short u) { return __uint_as_float((unsigned)u << 16); }
__device__ __forceinline__ float wave_sum(float v) {
#pragma unroll
    for (int o = 1; o < 64; o <<= 1) v += __shfl_xor(v, o);
    return v;
}
__device__ __forceinline__ void tr_item(const float* W, int N, bf16* WT, int ldk, int k0, int dst_n0, int src_n0, const float* fold, LAS float* scr, int lane) {
    float tv[32];
#pragma unroll
    for (int i = 0; i < 32; ++i) tv[i] = W[(size_t)(k0 + 2 * i + (lane >> 5)) * N + src_n0 + (lane & 31)];
#pragma unroll
    for (int i = 0; i < 32; ++i) { const int kk = 2 * i + (lane >> 5); float v = tv[i]; if (fold) v *= fold[k0 + kk]; scr[kk * 33 + (lane & 31)] = v; }
    LDS_WAIT(); asm volatile("" ::: "memory");
    const int c = lane & 7;
#pragma unroll
    for (int j = 0; j < 4; ++j) { const int n = (lane >> 3) + 8 * j; const LAS float* s = scr + (8 * c) * 33 + n;
        v4u o; o.x = pk2(s[0 * 33], s[1 * 33]); o.y = pk2(s[2 * 33], s[3 * 33]); o.z = pk2(s[4 * 33], s[5 * 33]); o.w = pk2(s[6 * 33], s[7 * 33]);
        *(v4u*)(WT + (size_t)(dst_n0 + n) * ldk + k0 + 8 * c) = o; }
    LDS_WAIT(); asm volatile("" ::: "memory");
}
__device__ __forceinline__ int sig_swiglu(int n0) { const int pn = n0 >> 8, r = n0 & 255; return r < 128 ? 128 * pn + r : DFF + 128 * pn + (r - 128); }
__device__ __forceinline__ int sig_g64(int r) { return 64 * ((r & 127) >> 5) + 32 * (r >> 7); }
__device__ __forceinline__ int sig_win(int n0) { const int pn = n0 >> 8, r = n0 & 255;
    if (pn < 4) return 256 * pn + sig_g64(r);
    if (pn == 7 || pn == 8) return r < 128 ? 1792 + 128 * (pn - 7) + r : 2048 + 128 * (pn - 7) + (r - 128);
    return n0; }
template <int KIND> __device__ __forceinline__ void conv_item(const float* W, int K, int N, bf16* WT, int ldk, const float* fold, LAS float* scr, int item, int lane) {
    const int nblk = N / 32, kb = item / nblk, nb = item - kb * nblk, n0 = 32 * nb;
    int src = n0;
    if (KIND == 1) src = sig_swiglu(n0);
    if (KIND == 2) src = sig_win(n0);
    if (KIND == 3) src = sig_g64(n0);
    if (KIND == 4) src = n0 < 256 ? sig_g64(n0) : n0;
    tr_item(W, N, WT, ldk, 64 * kb, n0, src, fold, scr, lane);
}
__device__ __forceinline__ void poolfold_item(const float* pw, const float* pscale, const float* PB, bf16* WT, LAS float* scr, int item, int lane) {
    const int g = item >> 5, n0 = 32 * (item & 31), j = lane & 31, ch = lane >> 5;
    float a[32];
#pragma unroll
    for (int i = 0; i < 32; ++i) a[i] = 0.f;
    for (int d = 0; d < 64; ++d) { const float pv = PB[(size_t)(g * 64 + d) * DM + n0 + j] * pscale[g * 64 + d];
#pragma unroll
        for (int i = 0; i < 32; ++i) a[i] += pw[(size_t)(g * 64 + 2 * i + ch) * 64 + d] * pv; }
#pragma unroll
    for (int i = 0; i < 32; ++i) scr[(2 * i + ch) * 33 + j] = a[i];
    LDS_WAIT(); asm volatile("" ::: "memory");
    const int c = lane & 7;
#pragma unroll
    for (int jj = 0; jj < 4; ++jj) { const int n = (lane >> 3) + 8 * jj; const LAS float* s = scr + (8 * c) * 33 + n;
        v4u o; o.x = pk2(s[0 * 33], s[1 * 33]); o.y = pk2(s[2 * 33], s[3 * 33]); o.z = pk2(s[4 * 33], s[5 * 33]); o.w = pk2(s[6 * 33], s[7 * 33]);
        *(v4u*)(WT + (size_t)(n0 + n) * DM + 512 + g * 64 + 8 * c) = o; }
    LDS_WAIT(); asm volatile("" ::: "memory");
}
__device__ __forceinline__ void row_to_bf16(const float* xrow, bf16* orow, bf16* lrow, float* ssrow, int lane) {
    const f32x4* xr = (const f32x4*)xrow + lane;
    f32x4 v[4]; float s = 0.f;
#pragma unroll
    for (int j = 0; j < 4; ++j) { v[j] = xr[64 * j]; s += (v[j].x * v[j].x + v[j].y * v[j].y) + (v[j].z * v[j].z + v[j].w * v[j].w); }
    s = wave_sum(s);
    unsigned long long* o8 = (unsigned long long*)orow + lane;
#pragma unroll
    for (int j = 0; j < 4; ++j) { const unsigned p0 = pk2(v[j].x, v[j].y), p1 = pk2(v[j].z, v[j].w); o8[64 * j] = (unsigned long long)p0 | ((unsigned long long)p1 << 32);
        if (lrow) { const float r0 = __uint_as_float(p0 << 16), r1 = __uint_as_float(p0 & 0xffff0000u), r2 = __uint_as_float(p1 << 16), r3 = __uint_as_float(p1 & 0xffff0000u);
            ((unsigned long long*)lrow + lane)[64 * j] = (unsigned long long)pk2(v[j].x - r0, v[j].y - r1) | ((unsigned long long)pk2(v[j].z - r2, v[j].w - r3) << 32); } }
    if (lane < 16) ssrow[lane] = lane == 0 ? s : 0.f;
}

struct Args {
    const float* in[32]; float* out; unsigned char* ws; int ph_lo, ph_hi;
};
constexpr int TAB_OFF = 131072 + 1024;
__device__ __forceinline__ const float* ldp(int i) { extern __shared__ __attribute__((aligned(16))) unsigned char lds_tab_[]; unsigned off_ = TAB_OFF + 8 * i; asm volatile("" : "+v"(off_)); const LAS unsigned* t = (const LAS unsigned*)(lds_tab_ + off_);
    const unsigned lo = __builtin_amdgcn_readfirstlane(t[0]), hi = __builtin_amdgcn_readfirstlane(t[1]); return (const float*)(((unsigned long long)hi << 32) | lo); }
enum { I_X = 0, I_MEM, I_F1N, I_F1GU, I_F1D, I_MIXN, I_WIN, I_BG, I_DAQ, I_DAK, I_LAM, I_SUBLN, I_PA, I_POOLW, I_POOLS, I_PB, I_CDW, I_CDB, I_CLG, I_CLB, I_PC, I_WOUT,
       I_XAN, I_XAMN, I_XAQ, I_XAKV, I_XAQN, I_XAKN, I_XAO, I_F2N, I_F2GU, I_F2D };

__device__ __forceinline__ void convert_layer(unsigned char* wb, int l, LAS float* scr, int gw, int NGW, int lane) {
    constexpr int I_GU = (DM / 64) * (2 * DFF / 32), I_DN = (DFF / 64) * (DM / 32), I_IN = (DM / 64) * (INCOLS / 32), I_PAi = (512 / 64) * (DM / 32), I_PBi = 128, I_PCi = (256 / 64) * (DM / 32),
                  I_OUTi = (DM / 64) * (DM / 32), I_XQi = (DM / 64) * (256 / 32), I_XOi = (256 / 64) * (DM / 32);
    constexpr int NIT = 2 * I_GU + 2 * I_DN + I_IN + I_PAi + I_PBi + I_PCi + I_OUTi + I_XQi + I_XOi;
    for (int it = gw; it < NIT; it += NGW) {
        int r = it;
        if (r < I_GU) { conv_item<1>(ldp(I_F1GU) + (size_t)l * DM * 2 * DFF, DM, 2 * DFF, (bf16*)(wb + WB_GU1), DM, ldp(I_F1N) + l * DM, scr, r, lane); continue; } r -= I_GU;
        if (r < I_GU) { conv_item<1>(ldp(I_F2GU) + (size_t)l * DM * 2 * DFF, DM, 2 * DFF, (bf16*)(wb + WB_GU2), DM, ldp(I_F2N) + l * DM, scr, r, lane); continue; } r -= I_GU;
        if (r < I_IN) { conv_item<2>(ldp(I_WIN) + (size_t)l * DM * INCOLS, DM, INCOLS, (bf16*)(wb + WB_IN), DM, ldp(I_MIXN) + l * DM, scr, r, lane); continue; } r -= I_IN;
        if (r < I_DN) { conv_item<0>(ldp(I_F1D) + (size_t)l * DFF * DM, DFF, DM, (bf16*)(wb + WB_D1), DFF, nullptr, scr, r, lane); continue; } r -= I_DN;
        if (r < I_DN) { conv_item<0>(ldp(I_F2D) + (size_t)l * DFF * DM, DFF, DM, (bf16*)(wb + WB_D2), DFF, nullptr, scr, r, lane); continue; } r -= I_DN;
        if (r < I_OUTi) { conv_item<0>(ldp(I_WOUT) + (size_t)l * DM * DM, DM, DM, (bf16*)(wb + WB_OUT), DM, nullptr, scr, r, lane); continue; } r -= I_OUTi;
        if (r < I_PAi) { conv_item<0>(ldp(I_PA) + (size_t)l * 512 * DM, 512, DM, (bf16*)(wb + WB_PABC), DM, nullptr, scr, r, lane); continue; } r -= I_PAi;
        if (r < I_PCi) { conv_item<0>(ldp(I_PC) + (size_t)l * 256 * DM, 256, DM, (bf16*)(wb + WB_PABC) + 768, DM, nullptr, scr, r, lane); continue; } r -= I_PCi;
        if (r < I_XQi) { conv_item<3>(ldp(I_XAQ) + (size_t)l * DM * 256, DM, 256, (bf16*)(wb + WB_XQ), DM, ldp(I_XAN) + l * DM, scr, r, lane); continue; } r -= I_XQi;
        if (r < I_XOi) { conv_item<0>(ldp(I_XAO) + (size_t)l * 256 * DM, 256, DM, (bf16*)(wb + WB_XO), 256, nullptr, scr, r, lane); continue; } r -= I_XOi;
        poolfold_item(ldp(I_POOLW) + (size_t)l * 4 * 64 * 64, ldp(I_POOLS) + l * 256, ldp(I_PB) + (size_t)l * 256 * DM, (bf16*)(wb + WB_PABC), scr, r, lane);
    }
}
__device__ __forceinline__ void diff_rows(const bf16* O, bf16* oabc, const float* lamp, const float* subln, float lam_init, int gw, int NGW, int lane) {
    float t0 = lamp[lane] * lamp[64 + lane], t1 = lamp[128 + lane] * lamp[192 + lane];
    t0 = wave_sum(t0); t1 = wave_sum(t1);
    const float lam = __expf(t0) - __expf(t1) + lam_init, osc = 1.f - lam_init;
    const int h = lane >> 4, e0 = (lane & 15) * 8;
    f32x4 g0 = *(const f32x4*)(subln + e0), g1 = *(const f32x4*)(subln + e0 + 4);
    for (int rb = gw; rb < TOK; rb += 4 * NGW) {
      v4u w1[4], w2[4];
#pragma unroll
      for (int k = 0; k < 4; ++k) { const int row = rb + k * NGW; if (row < TOK) { const bf16* op = O + (size_t)row * 1024 + h * 256 + e0; w1[k] = *(const v4u*)op; w2[k] = *(const v4u*)(op + 128); } }
#pragma unroll
      for (int k = 0; k < 4; ++k) { const int row = rb + k * NGW; if (row >= TOK) break;
        f32x4 a0, a1, b0, b1; pg8::unpack8(w1[k], a0, a1); pg8::unpack8(w2[k], b0, b1);
        a0 -= b0 * lam; a1 -= b1 * lam;
        float ss = pg8::dot4(a0) + pg8::dot4(a1);
        ss += __shfl_xor(ss, 1); ss += __shfl_xor(ss, 2); ss += __shfl_xor(ss, 4); ss += __shfl_xor(ss, 8);
        const float r = rsqrtf(ss * (1.0f / 128.0f) + pg8::NEPS) * osc;
        *(v4u*)(oabc + (size_t)row * 1024 + h * 128 + e0) = pg8::pack8(a0 * g0 * r, a1 * g1 * r);
      }
    }
}
__device__ __forceinline__ void pool_rows(const bf16* zp, bf16* oabc, int gw, int NGW, int lane) {
    const int w = 2 << (lane >> 4), c0 = lane * 4;
    for (int row = gw; row < TOK; row += NGW) {
        const int pos = row & (SEQ - 1); const int cnt = pos + 1 < w ? pos + 1 : w;
        unsigned long long q[16];
#pragma unroll
        for (int j = 0; j < 16; ++j) q[j] = (j < cnt) ? *(const unsigned long long*)(zp + (size_t)(row - j) * 256 + c0) : 0ull;
        float s0 = 0.f, s1 = 0.f, s2 = 0.f, s3 = 0.f;
#pragma unroll
        for (int j = 0; j < 16; ++j) { s0 += __uint_as_float((unsigned)q[j] << 16); s1 += __uint_as_float((unsigned)q[j] & 0xffff0000u); s2 += __uint_as_float((unsigned)(q[j] >> 32) << 16); s3 += __uint_as_float((unsigned)(q[j] >> 32) & 0xffff0000u); }
        const float u0 = __uint_as_float((unsigned)q[0] << 16), u1 = __uint_as_float((unsigned)q[0] & 0xffff0000u), u2 = __uint_as_float((unsigned)(q[0] >> 32) << 16), u3 = __uint_as_float((unsigned)(q[0] >> 32) & 0xffff0000u);
        const float ic = 1.0f / (float)cnt;
        *(unsigned long long*)(oabc + (size_t)row * 1024 + 512 + c0) = (unsigned long long)pk2(s0 * ic - u0, s1 * ic - u1) | ((unsigned long long)pk2(s2 * ic - u2, s3 * ic - u3) << 32);
    }
}
__device__ __forceinline__ void conv_rows(const bf16* zc, bf16* oabc, const LAS float* dwl, const float* db, const float* lg, const float* lb, int gw, int NGW, int lane) {
    const int c0 = lane * 4;
    const f32x4 bias = *(const f32x4*)(db + c0), gg = *(const f32x4*)(lg + c0), bb = *(const f32x4*)(lb + c0);
    for (int ch = gw; ch < TOK / 8; ch += NGW) {
        const int row0 = ch * 8, pos0 = row0 & (SEQ - 1);
        f32x4 acc[8];
#pragma unroll
        for (int t = 0; t < 8; ++t) acc[t] = bias;
#pragma unroll
        for (int i = 0; i < 38; ++i) {
            if (pos0 - 30 + i >= 0) {
                const unsigned long long q = *(const unsigned long long*)(zc + (size_t)(row0 - 30 + i) * 256 + c0);
                f32x4 x; x[0] = __uint_as_float((unsigned)q << 16); x[1] = __uint_as_float((unsigned)q & 0xffff0000u); x[2] = __uint_as_float((unsigned)(q >> 32) << 16); x[3] = __uint_as_float((unsigned)(q >> 32) & 0xffff0000u);
#pragma unroll
                for (int t = 0; t < 8; ++t) { const int j = i - t; if (j >= 0 && j < 31) { const f32x4 wv = *(const LAS f32x4*)(dwl + j * 256 + c0); acc[t] += wv * x; } }
            }
        }
#pragma unroll
        for (int t = 0; t < 8; ++t) {
            float s = (acc[t][0] + acc[t][1]) + (acc[t][2] + acc[t][3]); s = wave_sum(s);
            const float mu = s * (1.0f / 256.0f); const f32x4 d = acc[t] - mu;
            float q2 = pg8::dot4(d); q2 = wave_sum(q2);
            const float r = rsqrtf(q2 * (1.0f / 256.0f) + pg8::NEPS);
            f32x4 y = d * r * gg + bb;
#pragma unroll
            for (int k = 0; k < 4; ++k) y[k] = y[k] * pg8::sigm(y[k]);
            *(unsigned long long*)(oabc + (size_t)(row0 + t) * 1024 + 768 + c0) = (unsigned long long)pk2(y[0], y[1]) | ((unsigned long long)pk2(y[2], y[3]) << 32);
        }
    }
}

#define RLX_AGENT __ATOMIC_RELAXED, __HIP_MEMORY_SCOPE_AGENT
#define XB_TMO      128
#define XB_XCNT(j)  (256  + 64 * (j))
#define XB_XSUB(j)  (1280 + 64 * (j))
#define XB_XGEN(j)  (2304 + 64 * (j))
#define XB_TOP      3328
#define XB_TOPGEN   3392
#define XCD_BAR_WORDS 3456
#define XB_SPIN_CAP (1u << 18)

__device__ __forceinline__ unsigned xb_ld(unsigned* p)              { return __hip_atomic_load(p, __ATOMIC_RELAXED, __HIP_MEMORY_SCOPE_AGENT); }
__device__ __forceinline__ unsigned xb_add(unsigned* p, unsigned v) { return __hip_atomic_fetch_add(p, v, __ATOMIC_RELAXED, __HIP_MEMORY_SCOPE_AGENT); }
__device__ __forceinline__ unsigned xb_xcc_id() { return (unsigned)__builtin_amdgcn_s_getreg((3 << 11) | 20) & 0xFu; }
#define XB_SPIN(cond, bar) do { unsigned _sp = 0; while (cond) { __builtin_amdgcn_s_sleep(1); \
    if ((++_sp & 255u) == 0u) { if (xb_ld(&(bar)[XB_TMO])) break; if (_sp > XB_SPIN_CAP) { atomicAdd(&(bar)[XB_TMO], 1u); break; } } } } while (0)

struct XcdBarrier {
    unsigned* bar; unsigned x;
    volatile LAS unsigned* st;
};

__device__ __forceinline__ XcdBarrier xcd_barrier_post(unsigned* bar, volatile LAS unsigned* st, int tid) {
    XcdBarrier b; b.bar = bar; b.x = xb_xcc_id(); b.st = st;
    if (tid == 0) (void)xb_add(&bar[XB_XCNT(b.x)], 1u);
    return b;
}
__device__ __forceinline__ void xcd_barrier_complete(unsigned* bar, unsigned x, unsigned& nloc, unsigned& nx) {
    const unsigned G = gridDim.x * gridDim.y * gridDim.z;
    unsigned sum, cnt, mine, sp = 0u;
    for (;;) {
        sum = 0u; cnt = 0u; mine = 0u;
#pragma unroll 1
        for (unsigned j = 0; j < 16; ++j) { const unsigned c = xb_ld(&bar[XB_XCNT(j)]); sum += c; cnt += (c > 0u) ? 1u : 0u; mine = (j == x) ? c : mine; }
        if (sum == G) break;
        __builtin_amdgcn_s_sleep(1);
        if ((++sp & 255u) == 0u) { if (xb_ld(&bar[XB_TMO])) break; if (sp > XB_SPIN_CAP) { atomicAdd(&bar[XB_TMO], 1u); break; } }
    }
    nloc = mine > 0u ? mine : 1u; nx = cnt > 0u ? cnt : 1u;
}

__device__ __forceinline__ void xcd_barrier(const XcdBarrier& b, int tid) {
    asm volatile("s_waitcnt vmcnt(0)" ::: "memory");
    __syncthreads();
    if (tid == 0) {
        unsigned* bar = b.bar;
        __builtin_amdgcn_s_waitcnt(0);
        unsigned nloc = b.st[0], nx = b.st[1];
        if (nloc == 0u) { xcd_barrier_complete(bar, b.x, nloc, nx); b.st[0] = nloc; b.st[1] = nx; }
        const unsigned old = xb_add(&bar[XB_XSUB(b.x)], 1u);
        const unsigned gen = old / nloc;
        if (old + 1u == (gen + 1u) * nloc) {
            __builtin_amdgcn_fence(__ATOMIC_RELEASE, "agent");
            asm volatile("s_waitcnt vmcnt(0)" ::: "memory");
            const unsigned og = xb_add(&bar[XB_TOP], 1u);
            const unsigned tg = og / nx;
            if (og + 1u == (tg + 1u) * nx) xb_add(&bar[XB_TOPGEN], 1u);
            else XB_SPIN(xb_ld(&bar[XB_TOPGEN]) == tg, bar);
            __builtin_amdgcn_fence(__ATOMIC_ACQUIRE, "agent");
            xb_add(&bar[XB_XGEN(b.x)], 1u);
            asm volatile("s_waitcnt vmcnt(0)" ::: "memory");
        } else {
            XB_SPIN(xb_ld(&bar[XB_XGEN(b.x)]) == gen, bar);
            __builtin_amdgcn_fence(__ATOMIC_ACQUIRE, "agent");
            asm volatile("s_waitcnt vmcnt(0)" ::: "memory");
        }
    }
    __syncthreads();
}

constexpr int PH_PER_LAYER = 13, NPHASE = 2 + DEPTH * PH_PER_LAYER;
template <unsigned MASK> __device__ __forceinline__ void mk_body(const Args& a) {
    extern __shared__ __attribute__((aligned(16))) unsigned char lds[];
    LAS unsigned char* ldsp = (LAS unsigned char*)lds;
    const int tid0 = threadIdx.x; const int wave0 = __builtin_amdgcn_readfirstlane(tid0 >> 6);
    if (tid0 == 0) { LAS unsigned long long* t = (LAS unsigned long long*)(ldsp + TAB_OFF);
        t[0] = (unsigned long long)a.in[0];
        t[1] = (unsigned long long)a.in[1];
        t[2] = (unsigned long long)a.in[2];
        t[3] = (unsigned long long)a.in[3];
        t[4] = (unsigned long long)a.in[4];
        t[5] = (unsigned long long)a.in[5];
        t[6] = (unsigned long long)a.in[6];
        t[7] = (unsigned long long)a.in[7];
        t[8] = (unsigned long long)a.in[8];
        t[9] = (unsigned long long)a.in[9];
        t[10] = (unsigned long long)a.in[10];
        t[11] = (unsigned long long)a.in[11];
        t[12] = (unsigned long long)a.in[12];
        t[13] = (unsigned long long)a.in[13];
        t[14] = (unsigned long long)a.in[14];
        t[15] = (unsigned long long)a.in[15];
        t[16] = (unsigned long long)a.in[16];
        t[17] = (unsigned long long)a.in[17];
        t[18] = (unsigned long long)a.in[18];
        t[19] = (unsigned long long)a.in[19];
        t[20] = (unsigned long long)a.in[20];
        t[21] = (unsigned long long)a.in[21];
        t[22] = (unsigned long long)a.in[22];
        t[23] = (unsigned long long)a.in[23];
        t[24] = (unsigned long long)a.in[24];
        t[25] = (unsigned long long)a.in[25];
        t[26] = (unsigned long long)a.in[26];
        t[27] = (unsigned long long)a.in[27];
        t[28] = (unsigned long long)a.in[28];
        t[29] = (unsigned long long)a.in[29];
        t[30] = (unsigned long long)a.in[30];
        t[31] = (unsigned long long)a.in[31];
    }
    if (tid0 < 4) ((LAS unsigned*)(ldsp + TAB_OFF + 512))[tid0] = 0u;
    __syncthreads();
    XcdBarrier gbar = xcd_barrier_post((unsigned*)a.ws + 1024, (volatile LAS unsigned*)(ldsp + TAB_OFF + 512), tid0);
    if (a.ph_lo < 0) cg::this_grid().sync();
    bool first = true;
    for (int ph = a.ph_lo; ph < a.ph_hi; ++ph) {
        if (ph < NPHASE - 1 && (ph - 1) % PH_PER_LAYER == 0) continue;
        int G = gridDim.x, bx = blockIdx.x; asm volatile("" : "+s"(G), "+s"(bx));
        const int vcu = (G % 8 == 0) ? (bx % 8) * (G / 8) + bx / 8 : bx, NGW = G * NWAVES;
        unsigned zz = 0u; asm volatile("v_mov_b32 %0, 0" : "=v"(zz));
        int tid = wave0 * 64 + (int)__builtin_amdgcn_mbcnt_hi(~0u, __builtin_amdgcn_mbcnt_lo(~0u, zz)); asm volatile("" : "+v"(tid));
        const int lane = tid & 63, wave = __builtin_amdgcn_readfirstlane(tid >> 6), gw = vcu * NWAVES + wave;
        LAS float* scr = (LAS float*)(ldsp + wave * 16384);
        GAS unsigned char* wsg_ = (GAS unsigned char*)a.ws; asm volatile("" : "+s"(wsg_)); unsigned char* ws = (unsigned char*)wsg_;
        float* SS = (float*)(ws + WS_SS); float* SSM = (float*)(ws + WS_SSM);
        bf16* MEMB = (bf16*)(ws + WS_MEMB); bf16* KX = (bf16*)(ws + WS_KX); bf16* VX = (bf16*)(ws + WS_VX); bf16* WKV = (bf16*)(ws + WS_WKV);
        bf16* XB = (bf16*)(ws + WS_XB);
        bf16 *ZQ = (bf16*)(ws + WS_ZQ), *ZK = (bf16*)(ws + WS_ZK), *ZV = (bf16*)(ws + WS_ZV), *ZP = (bf16*)(ws + WS_ZP), *ZC = (bf16*)(ws + WS_ZC), *GT = (bf16*)(ws + WS_G);
        bf16 *HB = (bf16*)(ws + WS_H), *OABC = (bf16*)(ws + WS_OABC), *MG = (bf16*)(ws + WS_MG), *QX = (bf16*)(ws + WS_QX), *OX = (bf16*)(ws + WS_OX);
        if (!first) { XcdBarrier gb; gb.bar = (unsigned*)ws + 1024; unsigned xx = gbar.x; asm volatile("" : "+s"(xx)); gb.x = xx; gb.st = (volatile LAS unsigned*)(ldsp + TAB_OFF + 512); xcd_barrier(gb, tid); }
        first = false;
        if (ph == 0) { if (EN(13)) {
            for (int m = gw; m < TOK; m += NGW) row_to_bf16(ldp(I_X) + (size_t)m * DM, XB + (size_t)m * DM, (bf16*)nullptr, SS + (size_t)m * 16, lane);
            for (int m = gw; m < MEMROWS; m += NGW) row_to_bf16(ldp(I_MEM) + (size_t)m * DM, MEMB + (size_t)m * DM, (bf16*)nullptr, SSM + (size_t)m * 16, lane);
            constexpr int I_KV = (DM / 64) * (512 / 32);
            for (int it = gw; it < DEPTH * I_KV; it += NGW) { const int l = it / I_KV, r = it - l * I_KV;
                conv_item<4>(ldp(I_XAKV) + (size_t)l * DM * 512, DM, 512, WKV + (size_t)l * 512 * DM, DM, ldp(I_XAMN) + l * DM, scr, r, lane); }
            { GAS unsigned char* og_ = (GAS unsigned char*)a.out; asm volatile("" : "+s"(og_)); convert_layer((unsigned char*)og_ + 64 * MiB, 0, scr, gw, NGW, lane); } }
            continue;
        }
        const int l = (ph - 1) / PH_PER_LAYER, st = (ph - 1) % PH_PER_LAYER;
        GAS float* outg_ = (GAS float*)a.out; asm volatile("" : "+s"(outg_)); float* outp = (float*)outg_;
        unsigned char* wb = (l & 1) ? ws + WS_WB : (unsigned char*)outp + 64 * MiB;
        switch (st) {
        case 0: if (EN(0)) {
            {
                for (size_t i = ((size_t)gw * 64 + lane) * 8; i < (size_t)TOK * DM; i += (size_t)NGW * 64 * 8) {
                    const v4u hwv = *(const v4u*)(XB + i); f32x4 h0, h1; pg8::unpack8(hwv, h0, h1);
                    *(f32x4*)(outp + i) = h0; *(f32x4*)(outp + i + 4) = h1; } }
        } break;
        case 1: case 11: { if (EN(1)) {
            pg8::Gemm g{XB, (const bf16*)(wb + (st == 1 ? WB_GU1 : WB_GU2)), DM, DM}; pg8::OrderStd S; S.init(TOK, 2 * DFF, DM, G, bx);
            pg8::EpiSwiglu E{HB, SS};
            pg8::gemm_phase<pg8::EpiSwiglu, pg8::OrderStd, true, true>(ldsp, g, S, E, tid);
        } } break;
        case 2: case 12: { if (EN(2)) {
            const bool cv = (st == 12) && (l + 1 < DEPTH);
            unsigned char* wbn = ((l + 1) & 1) ? ws + WS_WB : (unsigned char*)outp + 64 * MiB;
            if (st == 12 && l == DEPTH - 1) { pg8::Gemm g{HB, (const bf16*)(wb + WB_D2), DFF, DFF}; pg8::OrderStd S; S.init(TOK, DM, DFF, G, bx);
              pg8::EpiResidF32 E{XB, outp, 0.5f};
              pg8::gemm_phase<pg8::EpiResidF32, pg8::OrderStd, false, true>(ldsp, g, S, E, tid); }
            else { pg8::Gemm g{HB, (const bf16*)(wb + (st == 2 ? WB_D1 : WB_D2)), DFF, DFF}; pg8::OrderStd S; S.init(TOK, DM, DFF, G, bx);
              pg8::EpiResid E{XB, (bf16*)(ws + WS_XL), SS, 0.5f};
              pg8::gemm_phase<pg8::EpiResid, pg8::OrderStd, false, true>(ldsp, g, S, E, tid); }
            if (cv) { __syncthreads(); convert_layer(wbn, l + 1, scr, gw, NGW, lane); __syncthreads(); }
        } } break;
        case 3: { if (EN(3)) {
            pg8::Gemm g{XB, (const bf16*)(wb + WB_IN), DM, DM}; pg8::OrderStd S; S.init(TOK, INCOLS, DM, G, bx);
            pg8::EpiWin E{SS, ZQ, ZK, ZV, ZP, ZC, GT, ldp(I_DAQ) + l * 64, ldp(I_DAK) + l * 64, ldp(I_BG) + l * 3072};
            pg8::gemm_phase<pg8::EpiWin, pg8::OrderStd, true, true>(ldsp, g, S, E, tid);
        } } break;
        case 4: { if (EN(4)) {
            for (int it = vcu; it < 2048; it += G) {
                const int i = it >> 8, v = it & 255, bh = v >> 1, b = bh >> 4, hd = bh & 15, hc = hd >> 1, half = hd & 1, h = hd >> 2;
                const int aa = (v & 1) * 4 + (i >> 1), qb = (i & 1) ? 15 - aa : aa;
                const size_t r0 = (size_t)b * SEQ, rq = r0 + (size_t)qb * 256;
                attn_body::attn_unit<8, true>((const attn_body::bf16*)ZQ + rq * 512 + hc * 64, (const attn_body::bf16*)ZK + r0 * 512 + hc * 64, (const attn_body::bf16*)ZV + r0 * 512 + h * 128 + half * 64,
                                              (attn_body::bf16*)outp + rq * 1024 + hc * 128 + half * 64, 512, 512, 512, 1024, 4 * qb + 4, (char*)lds, tid);
            }
        } } break;
        case 5: { if (EN(5)) {
            const float lam_init = 0.8f - 0.6f * __expf(-0.3f * (float)l);
            LAS float* dwl = (LAS float*)ldsp;
            for (int i = tid; i < 31 * 256; i += NWAVES * 64) dwl[i] = ldp(I_CDW)[(size_t)l * 31 * 256 + i];
            __syncthreads();
            conv_rows(ZC, OABC, dwl, ldp(I_CDB) + l * 256, ldp(I_CLG) + l * 256, ldp(I_CLB) + l * 256, gw, NGW, lane);
            pool_rows(ZP, OABC, gw, NGW, lane);
            diff_rows((const bf16*)outp, OABC, ldp(I_LAM) + l * 256, ldp(I_SUBLN) + l * 128, lam_init, gw, NGW, lane);
            __syncthreads();
        } } break;
        case 6: { if (EN(6)) {
            pg8::Gemm g{OABC, (const bf16*)(wb + WB_PABC), DM, DM}; pg8::OrderSeg3 S; S.init(TOK, DM, G, bx);
            pg8::EpiMerged E{GT, MG, ldp(I_BG) + l * 3072};
            pg8::gemm_phase<pg8::EpiMerged, pg8::OrderSeg3, true, true>(ldsp, g, S, E, tid);
        } } break;
        case 7: { if (EN(7)) {
            pg8::Gemm g{MG, (const bf16*)(wb + WB_OUT), DM, DM}; pg8::OrderStd S; S.init(TOK, DM, DM, G, bx);
            pg8::EpiResid E{XB, (bf16*)(ws + WS_XL), SS, 1.0f};
            pg8::gemm_phase<pg8::EpiResid, pg8::OrderStd, false, true>(ldsp, g, S, E, tid);
        } } break;
        case 8: { if (EN(8)) {
            { pg8::Gemm g{XB, (const bf16*)(wb + WB_XQ), DM, DM}; pg8::OrderStd S; S.init(TOK, 256, DM, G, bx);
              pg8::EpiXq E{SS, QX, ldp(I_XAQN) + l * 64};
              pg8::gemm_phase<pg8::EpiXq, pg8::OrderStd, true, true>(ldsp, g, S, E, tid); }
            if (l == 0) { pg8::Gemm g{MEMB, WKV, DM, DM}; pg8::OrderStd S; S.init(MEMROWS, DEPTH * 512, DM, G, (bx + G / 2) % G);
              pg8::EpiMemKV E{SSM, KX, VX, ldp(I_XAKN)};
              pg8::gemm_phase<pg8::EpiMemKV, pg8::OrderStd, true, true>(ldsp, g, S, E, tid); }
        } } break;
        case 9: { if (EN(9)) {
            for (int it = vcu; it < 512; it += G) {
                const int i = it >> 8, v = it & 255, u = v * 2 + i, b = u >> 6, h = (u >> 4) & 3, qb = u & 15;
                const size_t rq = (size_t)b * SEQ + (size_t)qb * 256, rk = (size_t)l * MEMROWS + (size_t)b * NMEM;
                attn_body::attn_unit<8, false>((const attn_body::bf16*)QX + rq * 256 + h * 64, (const attn_body::bf16*)KX + rk * 256 + h * 64, (const attn_body::bf16*)VX + rk * 256 + h * 64,
                                               (attn_body::bf16*)OX + rq * 256 + h * 64, 256, 256, 256, 256, 4, (char*)lds, tid);
            }
        } } break;
        case 10: { if (EN(10)) {
            pg8::Gemm g{OX, (const bf16*)(wb + WB_XO), 256, 256}; pg8::OrderStd S; S.init(TOK, DM, 256, G, bx);
            pg8::EpiResid E{XB, (bf16*)(ws + WS_XL), SS, 1.0f};
            pg8::gemm_phase<pg8::EpiResid, pg8::OrderStd, false, true>(ldsp, g, S, E, tid);
        } } break;
        }
    }
}


#if MK_N_LAUNCHES == 1
__global__ void __launch_bounds__(NWAVES * 64, 2) mk_fwd(Args a) { mk_body<0xFFFFFFFFu>(a); }
#else
#define MK_KERN(name, mask) __global__ void __launch_bounds__(NWAVES * 64, 2) name(Args a) { mk_body<mask>(a); }
MK_KERN(mk_k_pro, 0x2001u)
MK_KERN(mk_k_up, 0x0002u)
MK_KERN(mk_k_down, 0x0004u)
MK_KERN(mk_k_win, 0x0008u)
MK_KERN(mk_k_attn, 0x0010u)
MK_KERN(mk_k_elem, 0x0020u)
MK_KERN(mk_k_merged, 0x0040u)
MK_KERN(mk_k_wout, 0x0080u)
MK_KERN(mk_k_xq, 0x0100u)
MK_KERN(mk_k_xattn, 0x0200u)
MK_KERN(mk_k_xo, 0x0400u)
#endif
extern "C" void kernel_launch(void* const* d_in, const int* in_sizes, int n_in, void* d_out, int out_size, void* d_ws, size_t ws_size, hipStream_t stream) {
    static int grid = 0;
    if (grid == 0) {
        if (n_in != 32 || in_sizes[0] != TOK * DM || out_size != TOK * DM || ws_size < WS_END) { fprintf(stderr, "kernel_launch: unexpected shapes (n_in %d, in0 %d, out %d, ws %zu < %zu)\n", n_in, n_in > 0 ? in_sizes[0] : -1, out_size, ws_size, (size_t)WS_END); grid = -1; return; }
        int dev = 0, cus = 0, per_cu = 0;
        (void)hipGetDevice(&dev); (void)hipDeviceGetAttribute(&cus, hipDeviceAttributeMultiprocessorCount, dev);
#if MK_N_LAUNCHES == 1
        if (hipFuncSetAttribute((const void*)mk_fwd, hipFuncAttributeMaxDynamicSharedMemorySize, LDS_TOTAL) != hipSuccess) { fprintf(stderr, "kernel_launch: hipFuncSetAttribute failed\n"); grid = -1; return; }
        (void)hipOccupancyMaxActiveBlocksPerMultiprocessor(&per_cu, (const void*)mk_fwd, NWAVES * 64, LDS_TOTAL);
#else
        { const void* ks[] = {(const void*)mk_k_pro, (const void*)mk_k_up, (const void*)mk_k_down, (const void*)mk_k_win, (const void*)mk_k_attn, (const void*)mk_k_elem, (const void*)mk_k_merged, (const void*)mk_k_wout, (const void*)mk_k_xq, (const void*)mk_k_xattn, (const void*)mk_k_xo};
          for (int i = 0; i < 11; ++i) if (hipFuncSetAttribute(ks[i], hipFuncAttributeMaxDynamicSharedMemorySize, LDS_TOTAL) != hipSuccess) { fprintf(stderr, "kernel_launch: hipFuncSetAttribute failed\n"); grid = -1; return; } }
        per_cu = 1;
#endif
        (void)hipGetLastError();
        if (per_cu < 1) per_cu = 1;
        grid = cus * per_cu;
        if (grid != 256) fprintf(stderr, "kernel_launch: note: grid %d (cus %d x %d)\n", grid, cus, per_cu);
    }
    if (grid < 0) return;
    Args a{};
    for (int i = 0; i < 32; ++i) a.in[i] = (const float*)d_in[i];
    a.out = (float*)d_out; a.ws = (unsigned char*)d_ws;
#if MK_N_LAUNCHES == 1
    if (hipMemsetAsync(d_ws, 0, 65536, stream) != hipSuccess) { fprintf(stderr, "kernel_launch: memset failed\n"); return; }
    a.ph_lo = 0; a.ph_hi = NPHASE - 1;
    void* args[] = {&a};
    hipError_t e = hipLaunchCooperativeKernel((const void*)mk_fwd, dim3(grid), dim3(NWAVES * 64), args, LDS_TOTAL, stream);
    if (e != hipSuccess) fprintf(stderr, "cooperative launch failed: %s (grid %d)\n", hipGetErrorString(e), grid);
#else
    for (int ph = 0; ph < NPHASE; ++ph) {
        if (ph == 1) continue;
        a.ph_lo = ph; a.ph_hi = ph + 1;
        const int st = ph == 0 ? -1 : (ph - 1) % PH_PER_LAYER;
        void (*k)(Args) = mk_k_pro;
        switch (st) { case 1: case 11: k = mk_k_up; break; case 2: case 12: k = mk_k_down; break; case 3: k = mk_k_win; break; case 4: k = mk_k_attn; break; case 5: k = mk_k_elem; break;
                      case 6: k = mk_k_merged; break; case 7: k = mk_k_wout; break; case 8: k = mk_k_xq; break; case 9: k = mk_k_xattn; break; case 10: k = mk_k_xo; break; default: break; }
        hipLaunchKernelGGL(k, dim3(grid), dim3(NWAVES * 64), LDS_TOTAL, stream, a);
    }
#endif
}
```

```cpp
#include <hip/hip_runtime.h>
#include <hip/hip_cooperative_groups.h>
#include <hip/hip_bf16.h>
#include <cstdio>
#include <cstdint>
#include <cmath>
namespace cg = cooperative_groups;
#ifndef MK_MASK
#define MK_MASK 0xFFFFFFFF
#endif
#define EN(k) ((MASK >> (k)) & 1u)
#ifndef MK_N_LAUNCHES
#define MK_N_LAUNCHES 1
#endif
namespace pg8 {
#define PG8_LAS __attribute__((address_space(3)))
typedef unsigned short bf16_t;
typedef short bf16x8 __attribute__((ext_vector_type(8)));
typedef float f32x4 __attribute__((ext_vector_type(4)));
typedef unsigned u32x4 __attribute__((ext_vector_type(4)));
constexpr int BM = 256, BK = 64, HALF = 128, HTB = HALF * BK * 2  , STAGE_BYTES = 8 * HTB, NXCD = 8, WGM = 8;

__host__ __device__ __forceinline__ int lds_byte(int r, int c) { const int st = (r >> 4) * 2 + (c >> 5), rr = r & 15, cc = c & 31, ob = rr * 64 + cc * 2; return st * 1024 + (ob ^ (((ob >> 9) & 1) << 5)); }
__host__ __device__ __forceinline__ void stage_rc(int b, int& R, int& C) { const int st = b / 1024, sb = b % 1024, swz = sb ^ (((sb >> 9) & 1) << 5); R = (st >> 1) * 16 + swz / 64; C = (st & 1) * 32 + (swz % 64) / 2; }
__host__ __device__ __forceinline__ int perm32(int rho) { const int n = rho >> 4, i = rho & 15; return 8 * (i >> 2) + 4 * n + (i & 3); }

struct Unit { int pm, pn, koff, nt, seg; };
struct Gemm { const bf16_t* A; const bf16_t* Bt; int lda, ldb; };

struct StaticOrder {
    int nM, nN, nwg, G, c;
    __host__ __device__ void init(int M, int N, int G_, int c_) { nM = M / BM; nN = N / BM; nwg = nM * nN; G = G_; c = c_; }
    __host__ __device__ bool next(int i, Unit& u) const {
        const long L = (long)i * G + c; if (L >= nwg) return false;
        int wgid = (int)L; { const int q = nwg / NXCD, r = nwg % NXCD, xcd = wgid % NXCD, off = wgid / NXCD; wgid = (xcd < r ? xcd * (q + 1) : r * (q + 1) + (xcd - r) * q) + off; }
        const int nig = WGM * nN, gid = wgid / nig, fm = gid * WGM, gsz = (nM - fm) < WGM ? (nM - fm) : WGM;
        u.pm = fm + ((wgid % nig) % gsz); u.pn = (wgid % nig) / gsz; return true;
    }
    __device__ __forceinline__ void a_ready(const Unit&) const {}
    __device__ __forceinline__ void done(const Unit&) const {}
};

typedef float f32x2 __attribute__((ext_vector_type(2)));
typedef unsigned u32x2 __attribute__((ext_vector_type(2)));
constexpr float NEPS = 1e-6f;
constexpr float QC2 = 0.125f * 1.4426950408889634f;
__device__ __forceinline__ unsigned cvt_pk_bf16(float lo, float hi) { unsigned r; asm volatile("v_cvt_pk_bf16_f32 %0, %1, %2" : "=v"(r) : "v"(lo), "v"(hi)); return r; }
__device__ __forceinline__ float sigm(float v) { return __builtin_amdgcn_rcpf(1.f + __builtin_amdgcn_exp2f(-1.4426950408889634f * v)); }
__device__ __forceinline__ u32x4 pack8(const f32x4 a, const f32x4 b) { u32x4 w; w.x = cvt_pk_bf16(a[0], a[1]); w.y = cvt_pk_bf16(a[2], a[3]); w.z = cvt_pk_bf16(b[0], b[1]); w.w = cvt_pk_bf16(b[2], b[3]); return w; }
__device__ __forceinline__ void unpack8(const u32x4 w, f32x4& a, f32x4& b) {
    a[0] = __uint_as_float(w.x << 16); a[1] = __uint_as_float(w.x & 0xffff0000u); a[2] = __uint_as_float(w.y << 16); a[3] = __uint_as_float(w.y & 0xffff0000u);
    b[0] = __uint_as_float(w.z << 16); b[1] = __uint_as_float(w.z & 0xffff0000u); b[2] = __uint_as_float(w.w << 16); b[3] = __uint_as_float(w.w & 0xffff0000u); }
__device__ __forceinline__ float row_rstd(const float* SS, int row, int fq) {
    const f32x4 p = *(const f32x4*)(SS + (size_t)row * 16 + 4 * fq);
    float s = (p[0] + p[1]) + (p[2] + p[3]);
    s += __shfl_xor(s, 16); s += __shfl_xor(s, 32);
    return rsqrtf(s * (1.0f / 1024.0f) + NEPS);
}
__device__ __forceinline__ void rows_rstd(const float* SS, int row0, int fq, float (&rs)[2][4]) {
    f32x4 p[2][4];
#pragma unroll
    for (int ai = 0; ai < 2; ++ai)
#pragma unroll
        for (int m = 0; m < 4; ++m) p[ai][m] = *(const f32x4*)(SS + (size_t)(row0 + ai * 128 + m * 16) * 16 + 4 * fq);
#pragma unroll
    for (int ai = 0; ai < 2; ++ai)
#pragma unroll
        for (int m = 0; m < 4; ++m) { float t = (p[ai][m][0] + p[ai][m][1]) + (p[ai][m][2] + p[ai][m][3]);
            t += __shfl_xor(t, 16); t += __shfl_xor(t, 32); rs[ai][m] = rsqrtf(t * (1.0f / 1024.0f) + NEPS); }
}
__device__ __forceinline__ float dot4(const f32x4 a) { return (a[0] * a[0] + a[1] * a[1]) + (a[2] * a[2] + a[3] * a[3]); }
typedef f32x4 acc_t[2][2][4][2];

struct EpiSwiglu {
    static constexpr bool PERM = true, AFTER_DRAIN = false; __device__ __forceinline__ bool keep(const Unit&) const { return false; }
    bf16_t* H; const float* SS;
    __device__ __forceinline__ void operator()(const acc_t& acc, const Unit& u, int wr, int wc, int fr, int fq) const {
        const int row0 = u.pm * BM + wr * 64 + fr, col = u.pn * 128 + wc * 32 + 8 * fq;
        float rsv[2][4]; rows_rstd(SS, row0, fq, rsv);
#pragma unroll
        for (int ai = 0; ai < 2; ++ai)
#pragma unroll
            for (int m = 0; m < 4; ++m) { const int row = row0 + ai * HALF + m * 16; const float rs = rsv[ai][m];
                f32x4 h[2];
#pragma unroll
                for (int n = 0; n < 2; ++n) { const f32x4 g = acc[ai][0][m][n] * rs, up = acc[ai][1][m][n] * rs;
#pragma unroll
                    for (int i = 0; i < 4; ++i) h[n][i] = g[i] * sigm(g[i]) * up[i]; }
                *(u32x4*)(H + (size_t)row * 2816 + col) = pack8(h[0], h[1]); }
    }
};
struct EpiResid {
    static constexpr bool PERM = true, AFTER_DRAIN = false; __device__ __forceinline__ bool keep(const Unit&) const { return false; }
    bf16_t* XB; bf16_t* XL; float* SS; float alpha;
    __device__ __forceinline__ void operator()(const acc_t& acc, const Unit& u, int wr, int wc, int fr, int fq) const {
        const int row0 = u.pm * BM + wr * 64 + fr, col0 = u.pn * BM + wc * 32 + 8 * fq;
        u32x4 hwa[2][4][2];
#pragma unroll
        for (int ai = 0; ai < 2; ++ai)
#pragma unroll
            for (int m = 0; m < 4; ++m)
#pragma unroll
                for (int bj = 0; bj < 2; ++bj) hwa[ai][m][bj] = *(const u32x4*)(XB + (size_t)(row0 + ai * HALF + m * 16) * 1024 + col0 + bj * HALF);
#pragma unroll
        for (int ai = 0; ai < 2; ++ai) {
#pragma unroll
            for (int m = 0; m < 4; ++m) { const int row = row0 + ai * HALF + m * 16; float ss = 0.f;
#pragma unroll
                for (int bj = 0; bj < 2; ++bj) { const size_t c = (size_t)row * 1024 + col0 + bj * HALF;
                    f32x4 h0, h1; unpack8(hwa[ai][m][bj], h0, h1);
                    const f32x4 o0 = h0 + acc[ai][bj][m][0] * alpha, o1 = h1 + acc[ai][bj][m][1] * alpha;
                    *(u32x4*)(XB + c) = pack8(o0, o1);
                    ss += dot4(o0) + dot4(o1); }
                ss += __shfl_xor(ss, 16); ss += __shfl_xor(ss, 32);
                if (fq == 0) SS[(size_t)row * 16 + u.pn * 4 + wc] = ss; }
            asm volatile("" ::: "memory"); }
    }
};
struct EpiResidF32 {
    static constexpr bool PERM = true, AFTER_DRAIN = false; __device__ __forceinline__ bool keep(const Unit&) const { return false; }
    bf16_t* XB; float* outf; float alpha;
    __device__ __forceinline__ void operator()(const acc_t& acc, const Unit& u, int wr, int wc, int fr, int fq) const {
        const int row0 = u.pm * BM + wr * 64 + fr, col0 = u.pn * BM + wc * 32 + 8 * fq;
        u32x4 hwa[2][4][2];
#pragma unroll
        for (int ai = 0; ai < 2; ++ai)
#pragma unroll
            for (int m = 0; m < 4; ++m)
#pragma unroll
                for (int bj = 0; bj < 2; ++bj) hwa[ai][m][bj] = *(const u32x4*)(XB + (size_t)(row0 + ai * HALF + m * 16) * 1024 + col0 + bj * HALF);
#pragma unroll
        for (int ai = 0; ai < 2; ++ai) {
#pragma unroll
            for (int m = 0; m < 4; ++m) { const int row = row0 + ai * HALF + m * 16; float ss = 0.f;
#pragma unroll
                for (int bj = 0; bj < 2; ++bj) { const size_t c = (size_t)row * 1024 + col0 + bj * HALF;
                    f32x4 h0, h1; unpack8(hwa[ai][m][bj], h0, h1);
                    const f32x4 o0 = h0 + acc[ai][bj][m][0] * alpha, o1 = h1 + acc[ai][bj][m][1] * alpha;
                    *(f32x4*)(outf + c) = o0; *(f32x4*)(outf + c + 4) = o1;
                    (void)ss; } }
            asm volatile("" ::: "memory"); }
    }
};
struct EpiWin {
    static constexpr bool PERM = true, AFTER_DRAIN = false; __device__ __forceinline__ bool keep(const Unit&) const { return false; }
    const float* SS; bf16_t *zq, *zk, *zv, *zp, *zc, *G; const float *gq, *gk, *bgate;
    __device__ __forceinline__ void operator()(const acc_t& acc, const Unit& u, int wr, int wc, int fr, int fq) const {
        const int pn = u.pn, row0 = u.pm * BM + wr * 64 + fr;
        float rsv[2][4]; rows_rstd(SS, row0, fq, rsv);
        if (pn < 4) {
            bf16_t* dst = pn < 2 ? zq : zk; int oz = 0; asm volatile("" : "+v"(oz)); const float* gp = (pn < 2 ? gq : gk) + 8 * fq + oz; const float sc = pn < 2 ? QC2 : 1.f; const int cb = (pn & 1) * 256 + wc * 64 + 8 * fq;
            f32x4 gv[2][2];
#pragma unroll
            for (int bj = 0; bj < 2; ++bj)
#pragma unroll
                for (int n = 0; n < 2; ++n) gv[bj][n] = *(const f32x4*)(gp + 32 * bj + 4 * n);
#pragma unroll
            for (int ai = 0; ai < 2; ++ai)
#pragma unroll
                for (int m = 0; m < 4; ++m) { const int row = row0 + ai * HALF + m * 16; const float rs = rsv[ai][m];
                    f32x4 v[2][2]; float ss = 0.f;
#pragma unroll
                    for (int bj = 0; bj < 2; ++bj)
#pragma unroll
                        for (int n = 0; n < 2; ++n) { v[bj][n] = acc[ai][bj][m][n] * rs; ss += dot4(v[bj][n]); }
                    ss += __shfl_xor(ss, 16); ss += __shfl_xor(ss, 32);
                    const float r2 = rsqrtf(ss * (1.0f / 64.0f) + NEPS) * sc;
#pragma unroll
                    for (int bj = 0; bj < 2; ++bj) *(u32x4*)(dst + (size_t)row * 512 + cb + 32 * bj) = pack8(v[bj][0] * gv[bj][0] * r2, v[bj][1] * gv[bj][1] * r2); }
        } else if (pn < 7) {
            bf16_t* dst = pn < 6 ? zv : zp; const int ld = pn < 6 ? 512 : 256, cb = (pn == 5 ? 256 : 0) + wc * 32 + 8 * fq;
#pragma unroll
            for (int ai = 0; ai < 2; ++ai)
#pragma unroll
                for (int m = 0; m < 4; ++m) { const int row = row0 + ai * HALF + m * 16; const float rs = rsv[ai][m];
#pragma unroll
                    for (int bj = 0; bj < 2; ++bj) *(u32x4*)(dst + (size_t)row * ld + cb + HALF * bj) = pack8(acc[ai][bj][m][0] * rs, acc[ai][bj][m][1] * rs); }
        } else if (pn < 9) {
            const int cb = (pn - 7) * 128 + wc * 32 + 8 * fq;
#pragma unroll
            for (int ai = 0; ai < 2; ++ai)
#pragma unroll
                for (int m = 0; m < 4; ++m) { const int row = row0 + ai * HALF + m * 16; const float rs = rsv[ai][m];
                    f32x4 h[2];
#pragma unroll
                    for (int n = 0; n < 2; ++n) { const f32x4 a = acc[ai][0][m][n] * rs, g = acc[ai][1][m][n] * rs;
#pragma unroll
                        for (int i = 0; i < 4; ++i) h[n][i] = a[i] * sigm(g[i]); }
                    *(u32x4*)(zc + (size_t)row * 256 + cb) = pack8(h[0], h[1]); }
        } else {
            const int cb = (pn - 9) * 256 + wc * 32 + 8 * fq;
#pragma unroll
            for (int ai = 0; ai < 2; ++ai)
#pragma unroll
                for (int m = 0; m < 4; ++m) { const int row = row0 + ai * HALF + m * 16; const float rs = rsv[ai][m];
#pragma unroll
                    for (int bj = 0; bj < 2; ++bj) *(u32x4*)(G + (size_t)row * 3072 + cb + HALF * bj) = pack8(acc[ai][bj][m][0] * rs, acc[ai][bj][m][1] * rs); }
        }
    }
};
struct EpiMerged {
    static constexpr bool PERM = true;  static constexpr bool AFTER_DRAIN = false;
    const bf16_t* G; bf16_t* Mg; const float* bg;
    __device__ __forceinline__ bool keep(const Unit& u) const { return u.seg < 2; }
    __device__ __forceinline__ void operator()(acc_t& acc, const Unit& u, int wr, int wc, int fr, int fq) const {
        const int row0 = u.pm * BM + wr * 64 + fr, cb = u.pn * BM + wc * 32 + 8 * fq, seg = u.seg;
        int oz = 0; asm volatile("" : "+v"(oz));
        constexpr float NL2E = -1.4426950408889634f;
        if (seg < 2) {
            f32x4 ba[2][2], bn[2][2];
#pragma unroll
            for (int bj = 0; bj < 2; ++bj)
#pragma unroll
                for (int n = 0; n < 2; ++n) { ba[bj][n] = *(const f32x4*)(bg + seg * 1024 + cb + oz + HALF * bj + 4 * n); bn[bj][n] = *(const f32x4*)(bg + (seg + 1) * 1024 + cb + oz + HALF * bj + 4 * n); }
#pragma unroll
            for (int ai = 0; ai < 2; ++ai)
#pragma unroll
                for (int mp = 0; mp < 2; ++mp) {
                    u32x4 ga[2][2], gn[2][2];
#pragma unroll
                    for (int mm = 0; mm < 2; ++mm)
#pragma unroll
                        for (int bj = 0; bj < 2; ++bj) { const bf16_t* gp = G + (size_t)(row0 + ai * HALF + (2 * mp + mm) * 16) * 3072 + seg * 1024 + cb + HALF * bj;
                            ga[mm][bj] = *(const u32x4*)gp; gn[mm][bj] = *(const u32x4*)(gp + 1024); }
#pragma unroll
                    for (int mm = 0; mm < 2; ++mm)
#pragma unroll
                        for (int bj = 0; bj < 2; ++bj) { const int m = 2 * mp + mm; f32x4 a0, a1, n0, n1; unpack8(ga[mm][bj], a0, a1); unpack8(gn[mm][bj], n0, n1);
#pragma unroll
                            for (int i = 0; i < 4; ++i) {
                                const float r0 = (1.f + __builtin_amdgcn_exp2f(NL2E * (n0[i] + bn[bj][0][i]))) * __builtin_amdgcn_rcpf(1.f + __builtin_amdgcn_exp2f(NL2E * (a0[i] + ba[bj][0][i])));
                                const float r1 = (1.f + __builtin_amdgcn_exp2f(NL2E * (n1[i] + bn[bj][1][i]))) * __builtin_amdgcn_rcpf(1.f + __builtin_amdgcn_exp2f(NL2E * (a1[i] + ba[bj][1][i])));
                                acc[ai][bj][m][0][i] *= r0; acc[ai][bj][m][1][i] *= r1; } }
                    asm volatile("" ::: "memory"); }
        } else {
            f32x4 ba[2][2];
#pragma unroll
            for (int bj = 0; bj < 2; ++bj)
#pragma unroll
                for (int n = 0; n < 2; ++n) ba[bj][n] = *(const f32x4*)(bg + 2048 + cb + oz + HALF * bj + 4 * n);
#pragma unroll
            for (int ai = 0; ai < 2; ++ai) {
                u32x4 ga[4][2];
#pragma unroll
                for (int m = 0; m < 4; ++m)
#pragma unroll
                    for (int bj = 0; bj < 2; ++bj) ga[m][bj] = *(const u32x4*)(G + (size_t)(row0 + ai * HALF + m * 16) * 3072 + 2048 + cb + HALF * bj);
#pragma unroll
                for (int m = 0; m < 4; ++m)
#pragma unroll
                    for (int bj = 0; bj < 2; ++bj) { f32x4 g0, g1; unpack8(ga[m][bj], g0, g1);
#pragma unroll
                        for (int i = 0; i < 4; ++i) { g0[i] = sigm(g0[i] + ba[bj][0][i]); g1[i] = sigm(g1[i] + ba[bj][1][i]); }
                        *(u32x4*)(Mg + (size_t)(row0 + ai * HALF + m * 16) * 1024 + cb + HALF * bj) = pack8(acc[ai][bj][m][0] * g0, acc[ai][bj][m][1] * g1); }
                asm volatile("" ::: "memory"); }
        }
    }
};
struct EpiXq {
    static constexpr bool PERM = true, AFTER_DRAIN = false; __device__ __forceinline__ bool keep(const Unit&) const { return false; }
    const float* SS; bf16_t* qx; const float* gq;
    __device__ __forceinline__ void operator()(const acc_t& acc, const Unit& u, int wr, int wc, int fr, int fq) const {
        const int row0 = u.pm * BM + wr * 64 + fr, cb = wc * 64 + 8 * fq; float rsv[2][4]; rows_rstd(SS, row0, fq, rsv); int oz = 0; asm volatile("" : "+v"(oz)); const float* gp = gq + 8 * fq + oz;
        f32x4 gv[2][2];
#pragma unroll
        for (int bj = 0; bj < 2; ++bj)
#pragma unroll
            for (int n = 0; n < 2; ++n) gv[bj][n] = *(const f32x4*)(gp + 32 * bj + 4 * n);
#pragma unroll
        for (int ai = 0; ai < 2; ++ai)
#pragma unroll
            for (int m = 0; m < 4; ++m) { const int row = row0 + ai * HALF + m * 16; const float rs = rsv[ai][m];
                f32x4 v[2][2]; float ss = 0.f;
#pragma unroll
                for (int bj = 0; bj < 2; ++bj)
#pragma unroll
                    for (int n = 0; n < 2; ++n) { v[bj][n] = acc[ai][bj][m][n] * rs; ss += dot4(v[bj][n]); }
                ss += __shfl_xor(ss, 16); ss += __shfl_xor(ss, 32);
                const float r2 = rsqrtf(ss * (1.0f / 64.0f) + NEPS) * QC2;
#pragma unroll
                for (int bj = 0; bj < 2; ++bj) *(u32x4*)(qx + (size_t)row * 256 + cb + 32 * bj) = pack8(v[bj][0] * gv[bj][0] * r2, v[bj][1] * gv[bj][1] * r2); }
    }
};
struct EpiMemKV {
    static constexpr bool PERM = true, AFTER_DRAIN = false; __device__ __forceinline__ bool keep(const Unit&) const { return false; }
    const float* SSM; bf16_t *KX, *VX; const float* gk;
    __device__ __forceinline__ void operator()(const acc_t& acc, const Unit& u, int wr, int wc, int fr, int fq) const {
        const int l = u.pn >> 1, row0 = u.pm * BM + wr * 64 + fr;
        float rsv[2][4]; rows_rstd(SSM, row0, fq, rsv);
        if ((u.pn & 1) == 0) {
            bf16_t* dst = KX + (size_t)l * 2048 * 256; int oz = 0; asm volatile("" : "+v"(oz)); const float* gp = gk + l * 64 + 8 * fq + oz; const int cb = wc * 64 + 8 * fq;
            f32x4 gv[2][2];
#pragma unroll
            for (int bj = 0; bj < 2; ++bj)
#pragma unroll
                for (int n = 0; n < 2; ++n) gv[bj][n] = *(const f32x4*)(gp + 32 * bj + 4 * n);
#pragma unroll
            for (int ai = 0; ai < 2; ++ai)
#pragma unroll
                for (int m = 0; m < 4; ++m) { const int row = row0 + ai * HALF + m * 16; const float rs = rsv[ai][m];
                    f32x4 v[2][2]; float ss = 0.f;
#pragma unroll
                    for (int bj = 0; bj < 2; ++bj)
#pragma unroll
                        for (int n = 0; n < 2; ++n) { v[bj][n] = acc[ai][bj][m][n] * rs; ss += dot4(v[bj][n]); }
                    ss += __shfl_xor(ss, 16); ss += __shfl_xor(ss, 32);
                    const float r2 = rsqrtf(ss * (1.0f / 64.0f) + NEPS);
#pragma unroll
                    for (int bj = 0; bj < 2; ++bj) *(u32x4*)(dst + (size_t)row * 256 + cb + 32 * bj) = pack8(v[bj][0] * gv[bj][0] * r2, v[bj][1] * gv[bj][1] * r2); }
        } else {
            bf16_t* dst = VX + (size_t)l * 2048 * 256; const int cb = wc * 32 + 8 * fq;
#pragma unroll
            for (int ai = 0; ai < 2; ++ai)
#pragma unroll
                for (int m = 0; m < 4; ++m) { const int row = row0 + ai * HALF + m * 16; const float rs = rsv[ai][m];
#pragma unroll
                    for (int bj = 0; bj < 2; ++bj) *(u32x4*)(dst + (size_t)row * 256 + cb + HALF * bj) = pack8(acc[ai][bj][m][0] * rs, acc[ai][bj][m][1] * rs); }
        }
    }
};
struct OrderStd {
    StaticOrder b; int nt;
    __device__ void init(int M, int N, int K, int G, int c) { b.init(M, N, G, c); nt = K / BK; }
    __device__ bool next(int i, Unit& u) const { if (!b.next(i, u)) return false; u.koff = 0; u.nt = nt; u.seg = 0; return true; }
    __device__ __forceinline__ void a_ready(const Unit&) const {}
    __device__ __forceinline__ void done(const Unit&) const {}
};
struct OrderSeg3 {
    StaticOrder b;
    __device__ void init(int M, int N, int G, int c) { b.init(M, N, G, c); }
    __device__ bool next(int i, Unit& u) const { const int t = i / 3, s = i - 3 * t; if (!b.next(t, u)) return false; u.seg = s; u.koff = s == 0 ? 0 : (s == 1 ? 512 : 768); u.nt = s == 0 ? 8 : 4; return true; }
    __device__ __forceinline__ void a_ready(const Unit&) const {}
    __device__ __forceinline__ void done(const Unit&) const {}
};
template <class Epi, class Sched, bool ALIGN_EPI = false, bool SP2 = false>
__device__ __forceinline__ void gemm_phase(PG8_LAS unsigned char* lds, const Gemm g, const Sched& S, const Epi& E, const int tid) {
    const int wid = __builtin_amdgcn_readfirstlane(tid >> 6), lane = tid & 63, wr = wid >> 2, wc = wid & 3, fr = lane & 15, fq = lane >> 4;
    unsigned voffA[2], voffB[2];
#pragma unroll
    for (int i = 0; i < 2; ++i) { int R, C; stage_rc(tid * 16 + i * 8192, R, C); const int Rb = Epi::PERM ? ((R & ~31) + perm32(R & 31)) : R;
        voffA[i] = (unsigned)(R * g.lda + C) * 2u; voffB[i] = (unsigned)(Rb * g.ldb + C) * 2u; }
    const size_t kstep = (size_t)(BK * 2);
    const size_t hstepA = (size_t)HALF * g.lda * 2, hstepB = (size_t)HALF * g.ldb * 2;
    const size_t tstepA = 2 * hstepA, tstepB = 2 * hstepB;
    const unsigned ldsw = (unsigned)wid * 1024u;
    const int aoff = lds_byte(wr * 64 + fr, fq * 8), boff = lds_byte(wc * 32 + fr, fq * 8);
#define PG8_SA(b, h) (((b) * 2 + (h)) * HTB)
#define PG8_SB(b, h) ((4 + (b) * 2 + (h)) * HTB)
#define PG8_STAGE(bufoff, gbase, voff) do { _Pragma("unroll") for (int _i = 0; _i < 2; ++_i) \
        __builtin_amdgcn_global_load_lds((const unsigned*)((const char*)(gbase) + (voff)[_i]), (PG8_LAS unsigned*)(lds + (bufoff) + ldsw + _i * 8192), 16, 0, 0); } while (0)
#define PG8_LDA(dst, b, h) do { _Pragma("unroll") for (int m = 0; m < 4; ++m) _Pragma("unroll") for (int k = 0; k < 2; ++k) dst[m][k] = *(const PG8_LAS bf16x8*)(lds + PG8_SA(b, h) + aoff + m * 2048 + k * 1024); } while (0)
#define PG8_LDB(dst, b, h) do { _Pragma("unroll") for (int n = 0; n < 2; ++n) _Pragma("unroll") for (int k = 0; k < 2; ++k) dst[n][k] = *(const PG8_LAS bf16x8*)(lds + PG8_SB(b, h) + boff + n * 2048 + k * 1024); } while (0)
#define PG8_MMA(ai, bj, At, Bt) do { __builtin_amdgcn_s_setprio(1); _Pragma("unroll") for (int m = 0; m < 4; ++m) _Pragma("unroll") for (int n = 0; n < 2; ++n) _Pragma("unroll") for (int k = 0; k < 2; ++k) \
        acc[ai][bj][m][n] = __builtin_amdgcn_mfma_f32_16x16x32_bf16(Bt[n][k], At[m][k], acc[ai][bj][m][n], 0, 0, 0); __builtin_amdgcn_s_setprio(0); } while (0)
#define PG8_WAIT_V(n) asm volatile("s_waitcnt vmcnt(" #n ")" ::: "memory")
#define PG8_WAIT_L(n) asm volatile("s_waitcnt lgkmcnt(" #n ")" ::: "memory")
#define PG8_BAR __builtin_amdgcn_s_barrier()
#define PG8_SCHED __builtin_amdgcn_sched_barrier(0)
    Unit cur, nxt; int ui = 0;
    if (!S.next(0, cur)) return;
    f32x4 acc[2][2][4][2];
#pragma unroll
    for (int a = 0; a < 2; ++a)
#pragma unroll
        for (int b = 0; b < 2; ++b)
#pragma unroll
            for (int m = 0; m < 4; ++m)
#pragma unroll
                for (int n = 0; n < 2; ++n) acc[a][b][m][n] = (f32x4){0.f, 0.f, 0.f, 0.f};
    bf16x8 At[4][2], B0[2][2], B1[2][2];
    const char* cA = (const char*)g.A + (size_t)cur.pm * tstepA + (size_t)cur.koff * 2; const char* cB = (const char*)g.Bt + (size_t)cur.pn * tstepB + (size_t)cur.koff * 2;
    S.a_ready(cur);
    if constexpr (SP2) {
        PG8_STAGE(PG8_SB(0, 0), cB, voffB); PG8_STAGE(PG8_SB(0, 1), cB + hstepB, voffB); PG8_STAGE(PG8_SA(0, 0), cA, voffA); PG8_STAGE(PG8_SA(0, 1), cA + hstepA, voffA);
        if (wr == 1) PG8_BAR;
        PG8_WAIT_V(2); PG8_BAR;
        PG8_STAGE(PG8_SB(1, 0), cB + kstep, voffB); PG8_STAGE(PG8_SA(1, 0), cA + kstep, voffA); PG8_STAGE(PG8_SB(1, 1), cB + hstepB + kstep, voffB);
        PG8_WAIT_V(6); PG8_BAR;
    } else {
        PG8_STAGE(PG8_SB(0, 0), cB, voffB); PG8_STAGE(PG8_SA(0, 0), cA, voffA); PG8_STAGE(PG8_SB(0, 1), cB + hstepB, voffB); PG8_STAGE(PG8_SA(0, 1), cA + hstepA, voffA);
        if (wr == 1) PG8_BAR;
        PG8_WAIT_V(4); PG8_BAR;
        PG8_STAGE(PG8_SB(1, 0), cB + kstep, voffB); PG8_STAGE(PG8_SA(1, 0), cA + kstep, voffA); PG8_STAGE(PG8_SB(1, 1), cB + hstepB + kstep, voffB);
        PG8_WAIT_V(6); PG8_BAR;
    }
    for (;;) {
        const bool has_next = S.next(ui + 1, nxt);
        const char* nA = has_next ? (const char*)g.A + (size_t)nxt.pm * tstepA + (size_t)nxt.koff * 2 : cA; const char* nB = has_next ? (const char*)g.Bt + (size_t)nxt.pn * tstepB + (size_t)nxt.koff * 2 : cB;
        const int nt = cur.nt;
        for (int t = 0; t < nt; t += 2) {
            const bool last = (t == nt - 2);
            const char* a1 = cA + (size_t)(t + 1) * kstep;
            const char* a2 = last ? nA : cA + (size_t)(t + 2) * kstep; const char* b2 = last ? nB : cB + (size_t)(t + 2) * kstep;
            const char* a3 = a2 + kstep; const char* b3 = b2 + kstep;
            if (last && has_next) S.a_ready(nxt);
            if constexpr (SP2) {
            PG8_LDB(B0, 0, 0); PG8_LDB(B1, 0, 1); PG8_SCHED; PG8_LDA(At, 0, 0); PG8_STAGE(PG8_SA(1, 1), a1 + hstepA, voffA);
            PG8_WAIT_V(8); PG8_WAIT_L(0); PG8_BAR; PG8_MMA(0, 0, At, B0); PG8_MMA(0, 1, At, B1); PG8_BAR; PG8_SCHED;
            PG8_LDA(At, 0, 1); PG8_STAGE(PG8_SB(0, 0), b2, voffB); PG8_STAGE(PG8_SB(0, 1), b2 + hstepB, voffB); PG8_STAGE(PG8_SA(0, 0), a2, voffA);
            PG8_WAIT_V(8); PG8_WAIT_L(0); PG8_BAR; PG8_MMA(1, 0, At, B0); PG8_MMA(1, 1, At, B1); PG8_BAR; PG8_SCHED;
            PG8_LDB(B0, 1, 0); PG8_LDB(B1, 1, 1); PG8_SCHED; PG8_LDA(At, 1, 0); PG8_STAGE(PG8_SA(0, 1), a2 + hstepA, voffA);
            PG8_WAIT_V(8); PG8_WAIT_L(0); PG8_BAR; PG8_MMA(0, 0, At, B0); PG8_MMA(0, 1, At, B1); PG8_BAR; PG8_SCHED;
            PG8_LDA(At, 1, 1); PG8_STAGE(PG8_SB(1, 0), b3, voffB); PG8_STAGE(PG8_SB(1, 1), b3 + hstepB, voffB); PG8_STAGE(PG8_SA(1, 0), a3, voffA);
            PG8_WAIT_V(8); PG8_WAIT_L(0); PG8_BAR; PG8_MMA(1, 0, At, B0); PG8_MMA(1, 1, At, B1); PG8_BAR; PG8_SCHED;
            } else {
            PG8_LDB(B0, 0, 0); PG8_SCHED; PG8_LDA(At, 0, 0); PG8_STAGE(PG8_SA(1, 1), a1 + hstepA, voffA);
            PG8_WAIT_L(8); PG8_BAR; PG8_WAIT_L(0); PG8_MMA(0, 0, At, B0); PG8_BAR; PG8_SCHED;
            PG8_LDB(B1, 0, 1); PG8_STAGE(PG8_SB(0, 0), b2, voffB);
            PG8_BAR; PG8_WAIT_L(0); PG8_MMA(0, 1, At, B1); PG8_BAR;
            PG8_LDA(At, 0, 1); PG8_STAGE(PG8_SA(0, 0), a2, voffA);
            PG8_BAR; PG8_WAIT_L(0); PG8_MMA(1, 0, At, B0); PG8_BAR; PG8_SCHED;
            PG8_STAGE(PG8_SB(0, 1), b2 + hstepB, voffB);
            PG8_WAIT_V(6); PG8_BAR; PG8_MMA(1, 1, At, B1); PG8_BAR;
            PG8_LDB(B0, 1, 0); PG8_SCHED; PG8_LDA(At, 1, 0); PG8_STAGE(PG8_SA(0, 1), a2 + hstepA, voffA);
            PG8_WAIT_L(8); PG8_BAR; PG8_WAIT_L(0); PG8_MMA(0, 0, At, B0); PG8_BAR; PG8_SCHED;
            PG8_LDB(B1, 1, 1); PG8_STAGE(PG8_SB(1, 0), b3, voffB);
            PG8_BAR; PG8_WAIT_L(0); PG8_MMA(0, 1, At, B1); PG8_BAR;
            PG8_LDA(At, 1, 1); PG8_STAGE(PG8_SA(1, 0), a3, voffA);
            PG8_BAR; PG8_WAIT_L(0); PG8_MMA(1, 0, At, B0); PG8_BAR; PG8_SCHED;
            PG8_STAGE(PG8_SB(1, 1), b3 + hstepB, voffB);
            PG8_WAIT_V(6); PG8_BAR; PG8_MMA(1, 1, At, B1); PG8_BAR;
            }
        }
        if constexpr (ALIGN_EPI) { if (wr == 0) PG8_BAR; }
        if constexpr (!Epi::AFTER_DRAIN) { E(acc, cur, wr, wc, fr, fq); S.done(cur); }
        if (!has_next) break;
        if (!E.keep(cur)) {
#pragma unroll
        for (int a = 0; a < 2; ++a)
#pragma unroll
            for (int b = 0; b < 2; ++b)
#pragma unroll
                for (int m = 0; m < 4; ++m)
#pragma unroll
                    for (int n = 0; n < 2; ++n) acc[a][b][m][n] = (f32x4){0.f, 0.f, 0.f, 0.f};
        }
        cur = nxt; cA = nA; cB = nB; ++ui;
        if constexpr (ALIGN_EPI) { if (wr == 1) PG8_BAR; }
    }
    PG8_WAIT_V(0);
    if constexpr (!ALIGN_EPI) { if (wr == 0) PG8_BAR; }
    PG8_BAR;
    if constexpr (Epi::AFTER_DRAIN) { E.fused(acc, cur, wr, wc, fr, fq, lds, wid, lane); S.done(cur); }
#undef PG8_SA
#undef PG8_SB
#undef PG8_STAGE
#undef PG8_LDA
#undef PG8_LDB
#undef PG8_MMA
#undef PG8_WAIT_V
#undef PG8_WAIT_L
#undef PG8_BAR
#undef PG8_SCHED
}
}
#include <hip/hip_bf16.h>
namespace attn_body {
using bf16=__hip_bfloat16;
using bf16x8=__attribute__((ext_vector_type(8)))short;
using s16x4=__attribute__((ext_vector_type(4)))short;
using f32x16=__attribute__((ext_vector_type(16)))float;
using u32x4=__attribute__((ext_vector_type(4)))unsigned;
constexpr int D=64;
constexpr int NW=8,QBLK=32,QB=QBLK*NW,KVBLK=64;
__device__ __forceinline__ int crow(int r,int hi){return (r&3)+8*(r>>2)+4*hi;}
#define SBAR() __builtin_amdgcn_sched_barrier(0)
__device__ __forceinline__ void cmask(f32x16&p0,f32x16&p1,int jb,int qrel,int hi){
  const float NEG=-INFINITY; int kb=64*jb+4*hi;
  #pragma unroll
  for(int r=0;r<16;++r){int kv=kb+(r&3)+8*(r>>2); if(kv>qrel)p0[r]=NEG; if(kv+32>qrel)p1[r]=NEG;}
}

constexpr int NSLOT=3, SLOTB=8192;
constexpr int LDS_K=0, LDS_V=NSLOT*SLOTB, LDS_WS=2*NSLOT*SLOTB, LDS_OST=LDS_WS+NW*64*4, LDS_BYTES=LDS_OST+NW*4096;
constexpr float C2=0.125f*1.4426950408889634f;
__device__ __forceinline__ void glds16(const void*gsrc,unsigned lds_dst){unsigned keep;
  asm volatile("s_mov_b32 %0, m0\n\ts_mov_b32 m0, %2\n\ts_nop 0\n\tglobal_load_lds_dwordx4 %1, off\n\ts_mov_b32 m0, %0":"=&s"(keep):"v"(gsrc),"s"(lds_dst):"memory");}
__device__ __forceinline__ float max3f(float a,float b,float c){float r;asm("v_max3_f32 %0, %1, %2, %3":"=v"(r):"v"(a),"v"(b),"v"(c));return r;}
__device__ __forceinline__ float max2f(float a,float b){float r;asm("v_max_f32_e32 %0, %1, %2":"=v"(r):"v"(a),"v"(b));return r;}
__device__ __forceinline__ float fadd_s(float a,float b){float r;asm("v_add_f32_e32 %0, %1, %2":"=v"(r):"v"(a),"v"(b));return r;}
__device__ __forceinline__ float fsub_s(float a,float b){float r;asm("v_sub_f32_e32 %0, %1, %2":"=v"(r):"v"(a),"v"(b));return r;}
typedef float f32x2_t __attribute__((ext_vector_type(2))); typedef __bf16 bf16x2_t __attribute__((ext_vector_type(2)));
__device__ __forceinline__ unsigned cvtpk_s(float lo,float hi){f32x2_t v={lo,hi};bf16x2_t b=__builtin_convertvector(v,bf16x2_t);return __builtin_bit_cast(unsigned,b);}
#define WAIT_BAR(N) asm volatile("s_waitcnt vmcnt(" #N ") lgkmcnt(0)\n\ts_barrier":::"memory")

__device__ __forceinline__ void qkt(f32x16&p0,f32x16&p1,const char*Kslot,const bf16x8*qr,const f32x16&negm,int r32,int hi){
  const char*kb=Kslot+hi*1024+r32*16;
  #pragma unroll
  for(int d0=0;d0<4;++d0){
    const bf16x8 b0=*reinterpret_cast<const bf16x8*>(kb+d0*2048);
    const bf16x8 b1=*reinterpret_cast<const bf16x8*>(kb+d0*2048+512);
    if(d0==0){p0=__builtin_amdgcn_mfma_f32_32x32x16_bf16(b0,qr[0],negm,0,0,0);p1=__builtin_amdgcn_mfma_f32_32x32x16_bf16(b1,qr[0],negm,0,0,0);}
    else{p0=__builtin_amdgcn_mfma_f32_32x32x16_bf16(b0,qr[d0],p0,0,0,0);p1=__builtin_amdgcn_mfma_f32_32x32x16_bf16(b1,qr[d0],p1,0,0,0);}}
}
typedef __attribute__((address_space(3))) const char* lds_cptr;
typedef short v4i16_t __attribute__((ext_vector_type(4)));
__device__ __forceinline__ void kload8(bf16x8*kf,lds_cptr kp){
  kf[0]=*(const __attribute__((address_space(3))) bf16x8*)(kp);      kf[1]=*(const __attribute__((address_space(3))) bf16x8*)(kp+512);
  kf[2]=*(const __attribute__((address_space(3))) bf16x8*)(kp+2048); kf[3]=*(const __attribute__((address_space(3))) bf16x8*)(kp+2560);
  kf[4]=*(const __attribute__((address_space(3))) bf16x8*)(kp+4096); kf[5]=*(const __attribute__((address_space(3))) bf16x8*)(kp+4608);
  kf[6]=*(const __attribute__((address_space(3))) bf16x8*)(kp+6144); kf[7]=*(const __attribute__((address_space(3))) bf16x8*)(kp+6656);
}
__device__ __forceinline__ void kload2(bf16x8*kf,lds_cptr kp,int j){ kf[2*j]=*(const __attribute__((address_space(3))) bf16x8*)(kp+j*2048); kf[2*j+1]=*(const __attribute__((address_space(3))) bf16x8*)(kp+j*2048+512); }
__device__ __forceinline__ s16x4 vtr(lds_cptr p){ return __builtin_bit_cast(s16x4,__builtin_amdgcn_ds_read_tr16_b64_v4i16((__attribute__((address_space(3))) v4i16_t*)p)); }
__device__ __forceinline__ float rowmax(const f32x16&p0,const f32x16&p1){
  float a=max3f(p0[0],p0[1],p1[0]),b=max3f(p0[2],p0[3],p1[1]);a=max3f(a,p1[2],p1[3]);
  #pragma unroll
  for(int r=4;r<16;r+=4){a=max3f(a,p0[r],p0[r+1]);b=max3f(b,p0[r+2],p0[r+3]);a=max3f(a,p1[r],p1[r+1]);b=max3f(b,p1[r+2],p1[r+3]);}
  const float m=max2f(a,b);
  auto rr=__builtin_amdgcn_permlane32_swap(__float_as_uint(m),__float_as_uint(m),false,false);
  return max2f(__uint_as_float(rr[0]),__uint_as_float(rr[1]));
}
__device__ __forceinline__ void pv(f32x16*o,int vb,bf16x8 pa0,bf16x8 pa1,bf16x8 pa2,bf16x8 pa3){
  #pragma unroll
  for(int d0=0;d0<2;++d0){s16x4 lo[4],hi[4];
    #pragma unroll
    for(int ks=0;ks<4;++ks){
      asm volatile("ds_read_b64_tr_b16 %0,%1 offset:%c2":"=&v"(lo[ks]):"v"(vb),"i"(d0*4096+ks*1024):"memory");
      asm volatile("ds_read_b64_tr_b16 %0,%1 offset:%c2":"=&v"(hi[ks]):"v"(vb),"i"(d0*4096+ks*1024+512):"memory");}
    asm volatile("s_waitcnt lgkmcnt(0)":::"memory");SBAR();
    #define PK(k) (bf16x8){lo[k][0],lo[k][1],lo[k][2],lo[k][3],hi[k][0],hi[k][1],hi[k][2],hi[k][3]}
    o[d0]=__builtin_amdgcn_mfma_f32_32x32x16_bf16(pa0,PK(0),o[d0],0,0,0);
    o[d0]=__builtin_amdgcn_mfma_f32_32x32x16_bf16(pa1,PK(1),o[d0],0,0,0);
    o[d0]=__builtin_amdgcn_mfma_f32_32x32x16_bf16(pa2,PK(2),o[d0],0,0,0);
    o[d0]=__builtin_amdgcn_mfma_f32_32x32x16_bf16(pa3,PK(3),o[d0],0,0,0);
    #undef PK
  }
}

#ifndef ATTN_STORE16
#define ATTN_STORE16(p,v) (*(u32x4*)(p)=(v))
#endif
template<int THRL,bool CAUSAL> __device__ __forceinline__ void attn_unit(const bf16*Qw0,const bf16*__restrict__ Kh,const bf16*__restrict__ Vh,bf16*Ow0,const int PQ,const int PK,const int PV,const int PO,const int NT,char*shm,const int tid){
  const int lane=tid&63,r32=lane&31,hi=lane>>5; const int wid=__builtin_amdgcn_readfirstlane(tid>>6);
  const bf16*Qw=Qw0+(long)(wid*QBLK)*PQ;
  const unsigned lds0=(unsigned)(uintptr_t)shm;
  float*wsf=(float*)(shm+LDS_WS)+wid*64;
  const bf16*ksrc=Kh+(long)lane*PK+wid*8;
  const bf16*vsrc=Vh+(long)(16*(wid&3)+(lane>>2))*PV+(wid>>2)*32+(lane&3)*8;
  const unsigned kdst=lds0+LDS_K+wid*1024, vdst=lds0+LDS_V+wid*1024;
  #define DMA_K(t,slot) glds16(ksrc+(long)(t)*KVBLK*PK,(unsigned)__builtin_amdgcn_readfirstlane(kdst+(slot)))
  #define DMA_V(t,slot) glds16(vsrc+(long)(t)*KVBLK*PV,(unsigned)__builtin_amdgcn_readfirstlane(vdst+(slot)))
  const int vb0=(int)(lds0+LDS_V)+((lane>>4)&1)*32+(lane&3)*8+(4*hi+((lane&15)>>2))*64;
  const char*Kbase=shm+LDS_K; bf16x8 kf[8];
  const lds_cptr shm3=(lds_cptr)shm; const lds_cptr kp0=shm3+LDS_K+hi*1024+r32*16; const lds_cptr vp0=shm3+LDS_V+((lane>>4)&1)*32+(lane&3)*8+(4*hi+((lane&15)>>2))*64;
  DMA_K(0,0);DMA_V(0,0);DMA_K(1,SLOTB);
  bf16x8 qr[4];
  #pragma unroll
  for(int d0=0;d0<4;++d0)qr[d0]=*reinterpret_cast<const bf16x8*>(&Qw[(long)r32*PQ+d0*16+hi*8]);
  const __attribute__((address_space(3))) char* qst=(const __attribute__((address_space(3))) char*)shm3+LDS_OST+wid*4096+lane*16;
  #pragma unroll
  for(int d0=0;d0<4;++d0)*(__attribute__((address_space(3))) bf16x8*)((__attribute__((address_space(3))) char*)shm3+LDS_OST+wid*4096+lane*16+d0*1024)=qr[d0];
  #define QRL(d) (*(const __attribute__((address_space(3))) bf16x8*)(qst+(d)*1024))
  float mhat=0.f,l_reg=0.f;f32x16 o[2];o[0]=f32x16{};o[1]=f32x16{};
  const int qrel=wid*QBLK+r32;
  #define CMASK(P0,P1,t) do{ if(CAUSAL){int jb_=(t)-(NT-4); if(jb_>=0)cmask(P0,P1,jb_,qrel,hi);} }while(0)
  bool resc=false;
  #define START(P0,P1) do{ const float rm=rowmax(P0,P1); resc=false; \
    { const float dl=rm; mhat=fadd_s(mhat,dl); \
      _Pragma("unroll") for(int r=0;r<16;++r){P0[r]=fsub_s(P0[r],dl);P1[r]=fsub_s(P1[r],dl);} \
      } \
    _Pragma("unroll") for(int r=0;r<16;++r)P0[r]=__builtin_amdgcn_exp2f(P0[r]); }while(0)
  #define RESC() do{ if(resc){ asm volatile("s_waitcnt lgkmcnt(0)":::"memory"); \
      _Pragma("unroll") for(int d_=0;d_<2;++d_) _Pragma("unroll") for(int r=0;r<16;++r)o[d_][r]*=wsf[crow(r,hi)]; } }while(0)
  f32x16 pA0,pA1,pB0,pB1;
  int sl_prev=0,sl_cur=0,sl_next=SLOTB;
  #define ROT() do{sl_prev=sl_cur;sl_cur=sl_next;sl_next=(sl_next==(NSLOT-1)*SLOTB)?0:sl_next+SLOTB;}while(0)
  DMA_K(2,2*SLOTB);
  WAIT_BAR(3);
  qkt(pA0,pA1,Kbase,qr,f32x16{},r32,hi);asm volatile("s_nop 15\n\ts_nop 7":"+v"(pA0),"+v"(pA1));CMASK(pA0,pA1,0);
  START(pA0,pA1);
  _Pragma("unroll") for(int r=0;r<16;++r)pA1[r]=__builtin_amdgcn_exp2f(pA1[r]);
  WAIT_BAR(0);
  DMA_K(3,0);DMA_V(1,SLOTB);
  ROT();
  kload8(kf,kp0+sl_cur);
  WAIT_BAR(2);
  s16x4 vlo[8],vhi[8]; u32x4 pw0,pw1,pw2,pw3;
  #define PKW(P,B) cvtpk_s(P[B],P[B+1])
  #define PAF(k) __builtin_bit_cast(bf16x8,pw##k)
  #define VFR(i) (bf16x8){vlo[i][0],vlo[i][1],vlo[i][2],vlo[i][3],vhi[i][0],vhi[i][1],vhi[i][2],vhi[i][3]}
  #define PIN(x) asm volatile("":"+v"(x))
  #define MX3(a,b,c) __builtin_fmaxf(__builtin_fmaxf((a),(b)),(c))
  #define GAPA(MF,A0,A1,A2,A3,W0,W1,PW) do{ MF; sacc+=A0; sacc+=A1; sacc+=A2; sacc+=A3; PIN(sacc); W0; W1; PIN(PW); SBAR(); }while(0)
  #define EX(v) __builtin_amdgcn_exp2f(v)
  #define GAPB(MF,X,B) do{ MF; X[B]=EX(X[B]); X[B+1]=EX(X[B+1]); X[B+2]=EX(X[B+2]); X[B+3]=EX(X[B+3]); PIN(X); SBAR(); }while(0)
  #define VRD(i) do{ vlo[i]=vtr(vp_+(((i)>>2)*4096+((i)&3)*1024)); vhi[i]=vtr(vp_+(((i)>>2)*4096+((i)&3)*1024+512)); }while(0)
  #define KRD(G,j) do{ if(G){ kload2(kf,kp0+sl_next,j); SBAR(); } }while(0)
  #define STEP(C0,C1,P0,P1,t,GK,GV,GL) do{ SBAR(); \
    const lds_cptr vp_=vp0+sl_prev; \
    VRD(0); SBAR(); float sacc=(P0[0]+P0[1]); \
    GAPA(C0=__builtin_amdgcn_mfma_f32_32x32x16_bf16(kf[0],QRL(0),f32x16{},0,0,0), P0[2],P0[3],P0[4],P0[5],     pw0[0]=PKW(P0,0), pw0[1]=PKW(P0,2), pw0); \
    VRD(4); SBAR(); GAPA(C1=__builtin_amdgcn_mfma_f32_32x32x16_bf16(kf[1],QRL(0),f32x16{},0,0,0), P0[6],P0[7],P0[8],P0[9],     pw0[2]=PKW(P0,4), pw0[3]=PKW(P0,6), pw0); \
    VRD(1); SBAR(); GAPA(C0=__builtin_amdgcn_mfma_f32_32x32x16_bf16(kf[2],QRL(1),C0,0,0,0),   P0[10],P0[11],P0[12],P0[13], pw1[0]=PKW(P0,8), pw1[1]=PKW(P0,10), pw1); \
    VRD(5); SBAR(); GAPA(C1=__builtin_amdgcn_mfma_f32_32x32x16_bf16(kf[3],QRL(1),C1,0,0,0),   P0[14],P0[15],P1[0],P1[1],   pw1[2]=PKW(P0,12),pw1[3]=PKW(P0,14), pw1); \
    VRD(2); SBAR(); GAPA(C0=__builtin_amdgcn_mfma_f32_32x32x16_bf16(kf[4],QRL(2),C0,0,0,0),   P1[2],P1[3],P1[4],P1[5],     pw2[0]=PKW(P1,0), pw2[1]=PKW(P1,2), pw2); \
    VRD(6); SBAR(); GAPA(C1=__builtin_amdgcn_mfma_f32_32x32x16_bf16(kf[5],QRL(2),C1,0,0,0),   P1[6],P1[7],P1[8],P1[9],     pw2[2]=PKW(P1,4), pw2[3]=PKW(P1,6), pw2); \
    VRD(3); SBAR(); GAPA(C0=__builtin_amdgcn_mfma_f32_32x32x16_bf16(kf[6],QRL(3),C0,0,0,0),   P1[10],P1[11],P1[12],P1[13], pw3[0]=PKW(P1,8), pw3[1]=PKW(P1,10), pw3); \
    VRD(7); SBAR(); GAPA(C1=__builtin_amdgcn_mfma_f32_32x32x16_bf16(kf[7],QRL(3),C1,0,0,0),   P1[14],P1[15],0.f,0.f,       pw3[2]=PKW(P1,12),pw3[3]=PKW(P1,14), pw3); \
    l_reg+=sacc; \
    if(GK){DMA_K((t)+3,sl_cur);} if(GV){DMA_V((t)+1,sl_next);} \
    { const float mh_=mhat; _Pragma("unroll") for(int r=0;r<16;++r){C0[r]-=mh_;C1[r]-=mh_;} } \
    CMASK(C0,C1,t); \
    { float a=MX3(C0[0],C0[1],C1[0]),b=MX3(C0[2],C0[3],C1[1]); a=MX3(a,C1[2],C1[3]); \
      _Pragma("unroll") for(int r=4;r<16;r+=4){a=MX3(a,C0[r],C0[r+1]);b=MX3(b,C0[r+2],C0[r+3]);a=MX3(a,C1[r],C1[r+1]);b=MX3(b,C1[r+2],C1[r+3]);} \
      float rm=__builtin_fmaxf(a,b); { auto rr=__builtin_amdgcn_permlane32_swap(__float_as_uint(rm),__float_as_uint(rm),false,false); rm=__builtin_fmaxf(__uint_as_float(rr[0]),__uint_as_float(rr[1])); } \
      resc=false; \
      if(__builtin_expect(__any(rm>(float)THRL),0)){ const float dl=__builtin_fmaxf(rm,0.f); mhat+=dl; \
        _Pragma("unroll") for(int r=0;r<16;++r){C0[r]-=dl;C1[r]-=dl;} \
        const float f=__builtin_amdgcn_exp2f(-dl); l_reg*=f; if(hi==0)wsf[r32]=f; resc=true; } } \
    SBAR(); \
    GAPB(o[0]=__builtin_amdgcn_mfma_f32_32x32x16_bf16(PAF(0),VFR(0),o[0],0,0,0), C0,0); \
    GAPB(o[1]=__builtin_amdgcn_mfma_f32_32x32x16_bf16(PAF(0),VFR(4),o[1],0,0,0), C0,4); \
    KRD(GL,0); GAPB(o[0]=__builtin_amdgcn_mfma_f32_32x32x16_bf16(PAF(1),VFR(1),o[0],0,0,0), C0,8); \
    KRD(GL,1); GAPB(o[1]=__builtin_amdgcn_mfma_f32_32x32x16_bf16(PAF(1),VFR(5),o[1],0,0,0), C0,12); \
    KRD(GL,2); GAPB(o[0]=__builtin_amdgcn_mfma_f32_32x32x16_bf16(PAF(2),VFR(2),o[0],0,0,0), C1,0); \
    KRD(GL,3); GAPB(o[1]=__builtin_amdgcn_mfma_f32_32x32x16_bf16(PAF(2),VFR(6),o[1],0,0,0), C1,4); \
    GAPB(o[0]=__builtin_amdgcn_mfma_f32_32x32x16_bf16(PAF(3),VFR(3),o[0],0,0,0), C1,8); \
    GAPB(o[1]=__builtin_amdgcn_mfma_f32_32x32x16_bf16(PAF(3),VFR(7),o[1],0,0,0), C1,12); \
    }while(0)
  int t=1;
  #undef CMASK
  #define CMASK(P0,P1,t) do{}while(0)
  for(;t+5<NT;t+=2){
    STEP(pB0,pB1,pA0,pA1,t,true,true,true);     WAIT_BAR(2); RESC(); ROT();
    STEP(pA0,pA1,pB0,pB1,t+1,true,true,true);   WAIT_BAR(2); RESC(); ROT();
  }
  #undef CMASK
  #define CMASK(P0,P1,t) do{ if(CAUSAL){int jb_=(t)-(NT-4); if(jb_>=0)cmask(P0,P1,jb_,qrel,hi);} }while(0)
  #define ENDW(tt) do{ if((tt)+3<NT){WAIT_BAR(2);} else if((tt)+2<NT){WAIT_BAR(1);} else {WAIT_BAR(0);} }while(0)
  for(;t+1<NT;t+=2){
    STEP(pB0,pB1,pA0,pA1,t,(t+3<NT),(t+1<NT),(t+1<NT));       ENDW(t);   RESC(); ROT();
    STEP(pA0,pA1,pB0,pB1,t+1,(t+4<NT),(t+2<NT),(t+2<NT));     ENDW(t+1); RESC(); ROT();
  }
  STEP(pB0,pB1,pA0,pA1,NT-1,false,false,false); RESC();
  { float sacc=pB0[0]+pB0[1]; _Pragma("unroll") for(int r=2;r<16;++r)sacc+=pB0[r]; _Pragma("unroll") for(int r=0;r<16;++r)sacc+=pB1[r]; l_reg+=sacc;
    pw0=(u32x4){PKW(pB0,0),PKW(pB0,2),PKW(pB0,4),PKW(pB0,6)};pw1=(u32x4){PKW(pB0,8),PKW(pB0,10),PKW(pB0,12),PKW(pB0,14)};pw2=(u32x4){PKW(pB1,0),PKW(pB1,2),PKW(pB1,4),PKW(pB1,6)};pw3=(u32x4){PKW(pB1,8),PKW(pB1,10),PKW(pB1,12),PKW(pB1,14)};
    SBAR(); pv(o,vb0+sl_cur,PAF(0),PAF(1),PAF(2),PAF(3)); }
  #undef PKW
  #undef PAF
  #undef VFR
  #undef PIN
  #undef MX3
  #undef GAPA
  #undef GAPB
  #undef EX
  #undef VRD
  #undef KRD
  #undef STEP
  #undef ENDW
  {auto rr=__builtin_amdgcn_permlane32_swap(__float_as_uint(l_reg),__float_as_uint(l_reg),false,false);l_reg=__uint_as_float(rr[0])+__uint_as_float(rr[1]);}
  if(hi==0)wsf[32+r32]=l_reg;asm volatile("s_waitcnt lgkmcnt(0)":::"memory");
  float rli[16];
  #pragma unroll
  for(int r=0;r<16;++r)rli[r]=__builtin_amdgcn_rcpf(wsf[32+crow(r,hi)]);
  bf16*Ow=Ow0+(long)(wid*QBLK)*PO;
  { bf16*stg=(bf16*)(shm+LDS_OST)+wid*2048;
    #pragma unroll
    for(int r=0;r<16;++r){const int orow=crow(r,hi);
      #pragma unroll
      for(int d0=0;d0<2;++d0)stg[orow*64+d0*32+r32]=__float2bfloat16(o[d0][r]*rli[r]);}
    asm volatile("s_waitcnt lgkmcnt(0)":::"memory");
    #pragma unroll
    for(int i=0;i<4;++i){const int row=i*8+(lane>>3),ch=lane&7; const u32x4 v=*(const u32x4*)(stg+row*64+ch*8); ATTN_STORE16(Ow+(long)row*PO+ch*8,v);} }
  asm volatile("s_waitcnt lgkmcnt(0)\n\ts_barrier":::"memory");
  #undef DMA_K
  #undef DMA_V
  #undef CMASK
  #undef START
  #undef RESC
  #undef ROT
}
constexpr int ATTN_LDS_BYTES=LDS_BYTES;
#undef SBAR
#undef WAIT_BAR
}
constexpr int NWAVES = 8;
constexpr int DEPTH = 4, DM = 1024, SEQ = 4096, NB = 8, TOK = NB * SEQ, DFF = 2816, NMEM = 256, MEMROWS = NB * NMEM, INCOLS = 5376;
constexpr size_t MiB = 1u << 20;
constexpr size_t WS_SS = 1 * MiB, WS_SSM = 3 * MiB, WS_MEMB = 4 * MiB, WS_KX = 8 * MiB, WS_VX = 12 * MiB, WS_WKV = 16 * MiB;
constexpr size_t WS_WB = 20 * MiB;
constexpr size_t WB_GU1 = 0, WB_D1 = WB_GU1 + (size_t)2 * DFF * DM * 2, WB_IN = WB_D1 + (size_t)DM * DFF * 2, WB_PABC = WB_IN + (size_t)INCOLS * DM * 2,
                 WB_OUT = WB_PABC + (size_t)DM * DM * 2, WB_XQ = WB_OUT + (size_t)DM * DM * 2, WB_XO = WB_XQ + (size_t)256 * DM * 2, WB_GU2 = WB_XO + (size_t)DM * 256 * 2,
                 WB_D2 = WB_GU2 + (size_t)2 * DFF * DM * 2, WB_END = WB_D2 + (size_t)DM * DFF * 2;
static_assert(WB_END <= 50 * MiB, "weights");
constexpr size_t WS_XB = 70 * MiB;
constexpr size_t WS_Z = 134 * MiB;
constexpr size_t WS_ZQ = WS_Z, WS_ZK = WS_Z + 32 * MiB, WS_ZV = WS_Z + 64 * MiB, WS_ZP = WS_Z + 96 * MiB, WS_ZC = WS_Z + 112 * MiB, WS_G = WS_Z + 128 * MiB;
constexpr size_t WS_H = WS_Z;
constexpr size_t WS_OABC = WS_Z, WS_MG = WS_Z + 64 * MiB;
constexpr size_t WS_QX = WS_Z, WS_OX = WS_Z + 16 * MiB;
constexpr size_t WS_XL = WS_G + (size_t)TOK * 3072 * 2;
constexpr size_t WS_END = WS_XL + (size_t)TOK * 1024 * 2;
static_assert(WS_H + (size_t)TOK * DFF * 2 <= WS_XL && WS_END <= 520 * MiB, "ws map");
constexpr int LDS_TOTAL = 147456;

#define GAS __attribute__((address_space(1)))
#define LAS __attribute__((address_space(3)))
typedef unsigned short bf16;
typedef unsigned v4u __attribute__((ext_vector_type(4)));
typedef float f32x4 __attribute__((ext_vector_type(4)));
#define LDS_WAIT() asm volatile("s_waitcnt lgkmcnt(0)" ::: "memory")
__device__ __forceinline__ unsigned pk2(float lo, float hi) { return pg8::cvt_pk_bf16(lo, hi); }
__device__ __forceinline__ float bf2f(unsigned short u) { return __uint_as_float((unsigned)u << 16); }
__device__ __forceinline__ float wave_sum(float v) {
#pragma unroll
    for (int o = 1; o < 64; o <<= 1) v += __shfl_xor(v, o);
    return v;
}
__device__ __forceinline__ void tr_item(const float* W, int N, bf16* WT, int ldk, int k0, int dst_n0, int src_n0, const float* fold, LAS float* scr, int lane) {
    float tv[32];
#pragma unroll
    for (int i = 0; i < 32; ++i) tv[i] = W[(size_t)(k0 + 2 * i + (lane >> 5)) * N + src_n0 + (lane & 31)];
#pragma unroll
    for (int i = 0; i < 32; ++i) { const int kk = 2 * i + (lane >> 5); float v = tv[i]; if (fold) v *= fold[k0 + kk]; scr[kk * 33 + (lane & 31)] = v; }
    LDS_WAIT(); asm volatile("" ::: "memory");
    const int c = lane & 7;
#pragma unroll
    for (int j = 0; j < 4; ++j) { const int n = (lane >> 3) + 8 * j; const LAS float* s = scr + (8 * c) * 33 + n;
        v4u o; o.x = pk2(s[0 * 33], s[1 * 33]); o.y = pk2(s[2 * 33], s[3 * 33]); o.z = pk2(s[4 * 33], s[5 * 33]); o.w = pk2(s[6 * 33], s[7 * 33]);
        *(v4u*)(WT + (size_t)(dst_n0 + n) * ldk + k0 + 8 * c) = o; }
    LDS_WAIT(); asm volatile("" ::: "memory");
}
__device__ __forceinline__ int sig_swiglu(int n0) { const int pn = n0 >> 8, r = n0 & 255; return r < 128 ? 128 * pn + r : DFF + 128 * pn + (r - 128); }
__device__ __forceinline__ int sig_g64(int r) { return 64 * ((r & 127) >> 5) + 32 * (r >> 7); }
__device__ __forceinline__ int sig_win(int n0) { const int pn = n0 >> 8, r = n0 & 255;
    if (pn < 4) return 256 * pn + sig_g64(r);
    if (pn == 7 || pn == 8) return r < 128 ? 1792 + 128 * (pn - 7) + r : 2048 + 128 * (pn - 7) + (r - 128);
    return n0; }
template <int KIND> __device__ __forceinline__ void conv_item(const float* W, int K, int N, bf16* WT, int ldk, const float* fold, LAS float* scr, int item, int lane) {
    const int nblk = N / 32, kb = item / nblk, nb = item - kb * nblk, n0 = 32 * nb;
    int src = n0;
    if (KIND == 1) src = sig_swiglu(n0);
    if (KIND == 2) src = sig_win(n0);
    if (KIND == 3) src = sig_g64(n0);
    if (KIND == 4) src = n0 < 256 ? sig_g64(n0) : n0;
    tr_item(W, N, WT, ldk, 64 * kb, n0, src, fold, scr, lane);
}
__device__ __forceinline__ void poolfold_item(const float* pw, const float* pscale, const float* PB, bf16* WT, LAS float* scr, int item, int lane) {
    const int g = item >> 5, n0 = 32 * (item & 31), j = lane & 31, ch = lane >> 5;
    float a[32];
#pragma unroll
    for (int i = 0; i < 32; ++i) a[i] = 0.f;
    for (int d = 0; d < 64; ++d) { const float pv = PB[(size_t)(g * 64 + d) * DM + n0 + j] * pscale[g * 64 + d];
#pragma unroll
        for (int i = 0; i < 32; ++i) a[i] += pw[(size_t)(g * 64 + 2 * i + ch) * 64 + d] * pv; }
#pragma unroll
    for (int i = 0; i < 32; ++i) scr[(2 * i + ch) * 33 + j] = a[i];
    LDS_WAIT(); asm volatile("" ::: "memory");
    const int c = lane & 7;
#pragma unroll
    for (int jj = 0; jj < 4; ++jj) { const int n = (lane >> 3) + 8 * jj; const LAS float* s = scr + (8 * c) * 33 + n;
        v4u o; o.x = pk2(s[0 * 33], s[1 * 33]); o.y = pk2(s[2 * 33], s[3 * 33]); o.z = pk2(s[4 * 33], s[5 * 33]); o.w = pk2(s[6 * 33], s[7 * 33]);
        *(v4u*)(WT + (size_t)(n0 + n) * DM + 512 + g * 64 + 8 * c) = o; }
    LDS_WAIT(); asm volatile("" ::: "memory");
}
__device__ __forceinline__ void row_to_bf16(const float* xrow, bf16* orow, bf16* lrow, float* ssrow, int lane) {
    const f32x4* xr = (const f32x4*)xrow + lane;
    f32x4 v[4]; float s = 0.f;
#pragma unroll
    for (int j = 0; j < 4; ++j) { v[j] = xr[64 * j]; s += (v[j].x * v[j].x + v[j].y * v[j].y) + (v[j].z * v[j].z + v[j].w * v[j].w); }
    s = wave_sum(s);
    unsigned long long* o8 = (unsigned long long*)orow + lane;
#pragma unroll
    for (int j = 0; j < 4; ++j) { const unsigned p0 = pk2(v[j].x, v[j].y), p1 = pk2(v[j].z, v[j].w); o8[64 * j] = (unsigned long long)p0 | ((unsigned long long)p1 << 32);
        if (lrow) { const float r0 = __uint_as_float(p0 << 16), r1 = __uint_as_float(p0 & 0xffff0000u), r2 = __uint_as_float(p1 << 16), r3 = __uint_as_float(p1 & 0xffff0000u);
            ((unsigned long long*)lrow + lane)[64 * j] = (unsigned long long)pk2(v[j].x - r0, v[j].y - r1) | ((unsigned long long)pk2(v[j].z - r2, v[j].w - r3) << 32); } }
    if (lane < 16) ssrow[lane] = lane == 0 ? s : 0.f;
}

struct Args {
    const float* in[32]; float* out; unsigned char* ws; int ph_lo, ph_hi;
};
constexpr int TAB_OFF = 131072 + 1024;
__device__ __forceinline__ const float* ldp(int i) { extern __shared__ __attribute__((aligned(16))) unsigned char lds_tab_[]; unsigned off_ = TAB_OFF + 8 * i; asm volatile("" : "+v"(off_)); const LAS unsigned* t = (const LAS unsigned*)(lds_tab_ + off_);
    const unsigned lo = __builtin_amdgcn_readfirstlane(t[0]), hi = __builtin_amdgcn_readfirstlane(t[1]); return (const float*)(((unsigned long long)hi << 32) | lo); }
enum { I_X = 0, I_MEM, I_F1N, I_F1GU, I_F1D, I_MIXN, I_WIN, I_BG, I_DAQ, I_DAK, I_LAM, I_SUBLN, I_PA, I_POOLW, I_POOLS, I_PB, I_CDW, I_CDB, I_CLG, I_CLB, I_PC, I_WOUT,
       I_XAN, I_XAMN, I_XAQ, I_XAKV, I_XAQN, I_XAKN, I_XAO, I_F2N, I_F2GU, I_F2D };

__device__ __forceinline__ void convert_layer(unsigned char* wb, int l, LAS float* scr, int gw, int NGW, int lane) {
    constexpr int I_GU = (DM / 64) * (2 * DFF / 32), I_DN = (DFF / 64) * (DM / 32), I_IN = (DM / 64) * (INCOLS / 32), I_PAi = (512 / 64) * (DM / 32), I_PBi = 128, I_PCi = (256 / 64) * (DM / 32),
                  I_OUTi = (DM / 64) * (DM / 32), I_XQi = (DM / 64) * (256 / 32), I_XOi = (256 / 64) * (DM / 32);
    constexpr int NIT = 2 * I_GU + 2 * I_DN + I_IN + I_PAi + I_PBi + I_PCi + I_OUTi + I_XQi + I_XOi;
    for (int it = gw; it < NIT; it += NGW) {
        int r = it;
        if (r < I_GU) { conv_item<1>(ldp(I_F1GU) + (size_t)l * DM * 2 * DFF, DM, 2 * DFF, (bf16*)(wb + WB_GU1), DM, ldp(I_F1N) + l * DM, scr, r, lane); continue; } r -= I_GU;
        if (r < I_GU) { conv_item<1>(ldp(I_F2GU) + (size_t)l * DM * 2 * DFF, DM, 2 * DFF, (bf16*)(wb + WB_GU2), DM, ldp(I_F2N) + l * DM, scr, r, lane); continue; } r -= I_GU;
        if (r < I_IN) { conv_item<2>(ldp(I_WIN) + (size_t)l * DM * INCOLS, DM, INCOLS, (bf16*)(wb + WB_IN), DM, ldp(I_MIXN) + l * DM, scr, r, lane); continue; } r -= I_IN;
        if (r < I_DN) { conv_item<0>(ldp(I_F1D) + (size_t)l * DFF * DM, DFF, DM, (bf16*)(wb + WB_D1), DFF, nullptr, scr, r, lane); continue; } r -= I_DN;
        if (r < I_DN) { conv_item<0>(ldp(I_F2D) + (size_t)l * DFF * DM, DFF, DM, (bf16*)(wb + WB_D2), DFF, nullptr, scr, r, lane); continue; } r -= I_DN;
        if (r < I_OUTi) { conv_item<0>(ldp(I_WOUT) + (size_t)l * DM * DM, DM, DM, (bf16*)(wb + WB_OUT), DM, nullptr, scr, r, lane); continue; } r -= I_OUTi;
        if (r < I_PAi) { conv_item<0>(ldp(I_PA) + (size_t)l * 512 * DM, 512, DM, (bf16*)(wb + WB_PABC), DM, nullptr, scr, r, lane); continue; } r -= I_PAi;
        if (r < I_PCi) { conv_item<0>(ldp(I_PC) + (size_t)l * 256 * DM, 256, DM, (bf16*)(wb + WB_PABC) + 768, DM, nullptr, scr, r, lane); continue; } r -= I_PCi;
        if (r < I_XQi) { conv_item<3>(ldp(I_XAQ) + (size_t)l * DM * 256, DM, 256, (bf16*)(wb + WB_XQ), DM, ldp(I_XAN) + l * DM, scr, r, lane); continue; } r -= I_XQi;
        if (r < I_XOi) { conv_item<0>(ldp(I_XAO) + (size_t)l * 256 * DM, 256, DM, (bf16*)(wb + WB_XO), 256, nullptr, scr, r, lane); continue; } r -= I_XOi;
        poolfold_item(ldp(I_POOLW) + (size_t)l * 4 * 64 * 64, ldp(I_POOLS) + l * 256, ldp(I_PB) + (size_t)l * 256 * DM, (bf16*)(wb + WB_PABC), scr, r, lane);
    }
}
__device__ __forceinline__ void diff_rows(const bf16* O, bf16* oabc, const float* lamp, const float* subln, float lam_init, int gw, int NGW, int lane) {
    float t0 = lamp[lane] * lamp[64 + lane], t1 = lamp[128 + lane] * lamp[192 + lane];
    t0 = wave_sum(t0); t1 = wave_sum(t1);
    const float lam = __expf(t0) - __expf(t1) + lam_init, osc = 1.f - lam_init;
    const int h = lane >> 4, e0 = (lane & 15) * 8;
    f32x4 g0 = *(const f32x4*)(subln + e0), g1 = *(const f32x4*)(subln + e0 + 4);
    for (int rb = gw; rb < TOK; rb += 4 * NGW) {
      v4u w1[4], w2[4];
#pragma unroll
      for (int k = 0; k < 4; ++k) { const int row = rb + k * NGW; if (row < TOK) { const bf16* op = O + (size_t)row * 1024 + h * 256 + e0; w1[k] = *(const v4u*)op; w2[k] = *(const v4u*)(op + 128); } }
#pragma unroll
      for (int k = 0; k < 4; ++k) { const int row = rb + k * NGW; if (row >= TOK) break;
        f32x4 a0, a1, b0, b1; pg8::unpack8(w1[k], a0, a1); pg8::unpack8(w2[k], b0, b1);
        a0 -= b0 * lam; a1 -= b1 * lam;
        float ss = pg8::dot4(a0) + pg8::dot4(a1);
        ss += __shfl_xor(ss, 1); ss += __shfl_xor(ss, 2); ss += __shfl_xor(ss, 4); ss += __shfl_xor(ss, 8);
        const float r = rsqrtf(ss * (1.0f / 128.0f) + pg8::NEPS) * osc;
        *(v4u*)(oabc + (size_t)row * 1024 + h * 128 + e0) = pg8::pack8(a0 * g0 * r, a1 * g1 * r);
      }
    }
}
__device__ __forceinline__ void pool_rows(const bf16* zp, bf16* oabc, int gw, int NGW, int lane) {
    const int w = 2 << (lane >> 4), c0 = lane * 4;
    for (int row = gw; row < TOK; row += NGW) {
        const int pos = row & (SEQ - 1); const int cnt = pos + 1 < w ? pos + 1 : w;
        unsigned long long q[16];
#pragma unroll
        for (int j = 0; j < 16; ++j) q[j] = (j < cnt) ? *(const unsigned long long*)(zp + (size_t)(row - j) * 256 + c0) : 0ull;
        float s0 = 0.f, s1 = 0.f, s2 = 0.f, s3 = 0.f;
#pragma unroll
        for (int j = 0; j < 16; ++j) { s0 += __uint_as_float((unsigned)q[j] << 16); s1 += __uint_as_float((unsigned)q[j] & 0xffff0000u); s2 += __uint_as_float((unsigned)(q[j] >> 32) << 16); s3 += __uint_as_float((unsigned)(q[j] >> 32) & 0xffff0000u); }
        const float u0 = __uint_as_float((unsigned)q[0] << 16), u1 = __uint_as_float((unsigned)q[0] & 0xffff0000u), u2 = __uint_as_float((unsigned)(q[0] >> 32) << 16), u3 = __uint_as_float((unsigned)(q[0] >> 32) & 0xffff0000u);
        const float ic = 1.0f / (float)cnt;
        *(unsigned long long*)(oabc + (size_t)row * 1024 + 512 + c0) = (unsigned long long)pk2(s0 * ic - u0, s1 * ic - u1) | ((unsigned long long)pk2(s2 * ic - u2, s3 * ic - u3) << 32);
    }
}
__device__ __forceinline__ void conv_rows(const bf16* zc, bf16* oabc, const LAS float* dwl, const float* db, const float* lg, const float* lb, int gw, int NGW, int lane) {
    const int c0 = lane * 4;
    const f32x4 bias = *(const f32x4*)(db + c0), gg = *(const f32x4*)(lg + c0), bb = *(const f32x4*)(lb + c0);
    for (int ch = gw; ch < TOK / 8; ch += NGW) {
        const int row0 = ch * 8, pos0 = row0 & (SEQ - 1);
        f32x4 acc[8];
#pragma unroll
        for (int t = 0; t < 8; ++t) acc[t] = bias;
#pragma unroll
        for (int i = 0; i < 38; ++i) {
            if (pos0 - 30 + i >= 0) {
                const unsigned long long q = *(const unsigned long long*)(zc + (size_t)(row0 - 30 + i) * 256 + c0);
                f32x4 x; x[0] = __uint_as_float((unsigned)q << 16); x[1] = __uint_as_float((unsigned)q & 0xffff0000u); x[2] = __uint_as_float((unsigned)(q >> 32) << 16); x[3] = __uint_as_float((unsigned)(q >> 32) & 0xffff0000u);
#pragma unroll
                for (int t = 0; t < 8; ++t) { const int j = i - t; if (j >= 0 && j < 31) { const f32x4 wv = *(const LAS f32x4*)(dwl + j * 256 + c0); acc[t] += wv * x; } }
            }
        }
#pragma unroll
        for (int t = 0; t < 8; ++t) {
            float s = (acc[t][0] + acc[t][1]) + (acc[t][2] + acc[t][3]); s = wave_sum(s);
            const float mu = s * (1.0f / 256.0f); const f32x4 d = acc[t] - mu;
            float q2 = pg8::dot4(d); q2 = wave_sum(q2);
            const float r = rsqrtf(q2 * (1.0f / 256.0f) + pg8::NEPS);
            f32x4 y = d * r * gg + bb;
#pragma unroll
            for (int k = 0; k < 4; ++k) y[k] = y[k] * pg8::sigm(y[k]);
            *(unsigned long long*)(oabc + (size_t)(row0 + t) * 1024 + 768 + c0) = (unsigned long long)pk2(y[0], y[1]) | ((unsigned long long)pk2(y[2], y[3]) << 32);
        }
    }
}

#define RLX_AGENT __ATOMIC_RELAXED, __HIP_MEMORY_SCOPE_AGENT
#define XB_TMO      128
#define XB_XCNT(j)  (256  + 64 * (j))
#define XB_XSUB(j)  (1280 + 64 * (j))
#define XB_XGEN(j)  (2304 + 64 * (j))
#define XB_TOP      3328
#define XB_TOPGEN   3392
#define XCD_BAR_WORDS 3456
#define XB_SPIN_CAP (1u << 18)

__device__ __forceinline__ unsigned xb_ld(unsigned* p)              { return __hip_atomic_load(p, __ATOMIC_RELAXED, __HIP_MEMORY_SCOPE_AGENT); }
__device__ __forceinline__ unsigned xb_add(unsigned* p, unsigned v) { return __hip_atomic_fetch_add(p, v, __ATOMIC_RELAXED, __HIP_MEMORY_SCOPE_AGENT); }
__device__ __forceinline__ unsigned xb_xcc_id() { return (unsigned)__builtin_amdgcn_s_getreg((3 << 11) | 20) & 0xFu; }
#define XB_SPIN(cond, bar) do { unsigned _sp = 0; while (cond) { __builtin_amdgcn_s_sleep(1); \
    if ((++_sp & 255u) == 0u) { if (xb_ld(&(bar)[XB_TMO])) break; if (_sp > XB_SPIN_CAP) { atomicAdd(&(bar)[XB_TMO], 1u); break; } } } } while (0)

struct XcdBarrier {
    unsigned* bar; unsigned x;
    volatile LAS unsigned* st;
};

__device__ __forceinline__ XcdBarrier xcd_barrier_post(unsigned* bar, volatile LAS unsigned* st, int tid) {
    XcdBarrier b; b.bar = bar; b.x = xb_xcc_id(); b.st = st;
    if (tid == 0) (void)xb_add(&bar[XB_XCNT(b.x)], 1u);
    return b;
}
__device__ __forceinline__ void xcd_barrier_complete(unsigned* bar, unsigned x, unsigned& nloc, unsigned& nx) {
    const unsigned G = gridDim.x * gridDim.y * gridDim.z;
    unsigned sum, cnt, mine, sp = 0u;
    for (;;) {
        sum = 0u; cnt = 0u; mine = 0u;
#pragma unroll 1
        for (unsigned j = 0; j < 16; ++j) { const unsigned c = xb_ld(&bar[XB_XCNT(j)]); sum += c; cnt += (c > 0u) ? 1u : 0u; mine = (j == x) ? c : mine; }
        if (sum == G) break;
        __builtin_amdgcn_s_sleep(1);
        if ((++sp & 255u) == 0u) { if (xb_ld(&bar[XB_TMO])) break; if (sp > XB_SPIN_CAP) { atomicAdd(&bar[XB_TMO], 1u); break; } }
    }
    nloc = mine > 0u ? mine : 1u; nx = cnt > 0u ? cnt : 1u;
}

__device__ __forceinline__ void xcd_barrier(const XcdBarrier& b, int tid) {
    asm volatile("s_waitcnt vmcnt(0)" ::: "memory");
    __syncthreads();
    if (tid == 0) {
        unsigned* bar = b.bar;
        __builtin_amdgcn_s_waitcnt(0);
        unsigned nloc = b.st[0], nx = b.st[1];
        if (nloc == 0u) { xcd_barrier_complete(bar, b.x, nloc, nx); b.st[0] = nloc; b.st[1] = nx; }
        const unsigned old = xb_add(&bar[XB_XSUB(b.x)], 1u);
        const unsigned gen = old / nloc;
        if (old + 1u == (gen + 1u) * nloc) {
            __builtin_amdgcn_fence(__ATOMIC_RELEASE, "agent");
            asm volatile("s_waitcnt vmcnt(0)" ::: "memory");
            const unsigned og = xb_add(&bar[XB_TOP], 1u);
            const unsigned tg = og / nx;
            if (og + 1u == (tg + 1u) * nx) xb_add(&bar[XB_TOPGEN], 1u);
            else XB_SPIN(xb_ld(&bar[XB_TOPGEN]) == tg, bar);
            __builtin_amdgcn_fence(__ATOMIC_ACQUIRE, "agent");
            xb_add(&bar[XB_XGEN(b.x)], 1u);
            asm volatile("s_waitcnt vmcnt(0)" ::: "memory");
        } else {
            XB_SPIN(xb_ld(&bar[XB_XGEN(b.x)]) == gen, bar);
            __builtin_amdgcn_fence(__ATOMIC_ACQUIRE, "agent");
            asm volatile("s_waitcnt vmcnt(0)" ::: "memory");
        }
    }
    __syncthreads();
}

constexpr int PH_PER_LAYER = 13, NPHASE = 2 + DEPTH * PH_PER_LAYER;
template <unsigned MASK> __device__ __forceinline__ void mk_body(const Args& a) {
    extern __shared__ __attribute__((aligned(16))) unsigned char lds[];
    LAS unsigned char* ldsp = (LAS unsigned char*)lds;
    const int tid0 = threadIdx.x; const int wave0 = __builtin_amdgcn_readfirstlane(tid0 >> 6);
    if (tid0 == 0) { LAS unsigned long long* t = (LAS unsigned long long*)(ldsp + TAB_OFF);
        t[0] = (unsigned long long)a.in[0];
        t[1] = (unsigned long long)a.in[1];
        t[2] = (unsigned long long)a.in[2];
        t[3] = (unsigned long long)a.in[3];
        t[4] = (unsigned long long)a.in[4];
        t[5] = (unsigned long long)a.in[5];
        t[6] = (unsigned long long)a.in[6];
        t[7] = (unsigned long long)a.in[7];
        t[8] = (unsigned long long)a.in[8];
        t[9] = (unsigned long long)a.in[9];
        t[10] = (unsigned long long)a.in[10];
        t[11] = (unsigned long long)a.in[11];
        t[12] = (unsigned long long)a.in[12];
        t[13] = (unsigned long long)a.in[13];
        t[14] = (unsigned long long)a.in[14];
        t[15] = (unsigned long long)a.in[15];
        t[16] = (unsigned long long)a.in[16];
        t[17] = (unsigned long long)a.in[17];
        t[18] = (unsigned long long)a.in[18];
        t[19] = (unsigned long long)a.in[19];
        t[20] = (unsigned long long)a.in[20];
        t[21] = (unsigned long long)a.in[21];
        t[22] = (unsigned long long)a.in[22];
        t[23] = (unsigned long long)a.in[23];
        t[24] = (unsigned long long)a.in[24];
        t[25] = (unsigned long long)a.in[25];
        t[26] = (unsigned long long)a.in[26];
        t[27] = (unsigned long long)a.in[27];
        t[28] = (unsigned long long)a.in[28];
        t[29] = (unsigned long long)a.in[29];
        t[30] = (unsigned long long)a.in[30];
        t[31] = (unsigned long long)a.in[31];
    }
    if (tid0 < 4) ((LAS unsigned*)(ldsp + TAB_OFF + 512))[tid0] = 0u;
    __syncthreads();
    XcdBarrier gbar = xcd_barrier_post((unsigned*)a.ws + 1024, (volatile LAS unsigned*)(ldsp + TAB_OFF + 512), tid0);
    if (a.ph_lo < 0) cg::this_grid().sync();
    bool first = true;
    for (int ph = a.ph_lo; ph < a.ph_hi; ++ph) {
        if (ph < NPHASE - 1 && (ph - 1) % PH_PER_LAYER == 0) continue;
        int G = gridDim.x, bx = blockIdx.x; asm volatile("" : "+s"(G), "+s"(bx));
        const int vcu = (G % 8 == 0) ? (bx % 8) * (G / 8) + bx / 8 : bx, NGW = G * NWAVES;
        unsigned zz = 0u; asm volatile("v_mov_b32 %0, 0" : "=v"(zz));
        int tid = wave0 * 64 + (int)__builtin_amdgcn_mbcnt_hi(~0u, __builtin_amdgcn_mbcnt_lo(~0u, zz)); asm volatile("" : "+v"(tid));
        const int lane = tid & 63, wave = __builtin_amdgcn_readfirstlane(tid >> 6), gw = vcu * NWAVES + wave;
        LAS float* scr = (LAS float*)(ldsp + wave * 16384);
        GAS unsigned char* wsg_ = (GAS unsigned char*)a.ws; asm volatile("" : "+s"(wsg_)); unsigned char* ws = (unsigned char*)wsg_;
        float* SS = (float*)(ws + WS_SS); float* SSM = (float*)(ws + WS_SSM);
        bf16* MEMB = (bf16*)(ws + WS_MEMB); bf16* KX = (bf16*)(ws + WS_KX); bf16* VX = (bf16*)(ws + WS_VX); bf16* WKV = (bf16*)(ws + WS_WKV);
        bf16* XB = (bf16*)(ws + WS_XB);
        bf16 *ZQ = (bf16*)(ws + WS_ZQ), *ZK = (bf16*)(ws + WS_ZK), *ZV = (bf16*)(ws + WS_ZV), *ZP = (bf16*)(ws + WS_ZP), *ZC = (bf16*)(ws + WS_ZC), *GT = (bf16*)(ws + WS_G);
        bf16 *HB = (bf16*)(ws + WS_H), *OABC = (bf16*)(ws + WS_OABC), *MG = (bf16*)(ws + WS_MG), *QX = (bf16*)(ws + WS_QX), *OX = (bf16*)(ws + WS_OX);
        if (!first) { XcdBarrier gb; gb.bar = (unsigned*)ws + 1024; unsigned xx = gbar.x; asm volatile("" : "+s"(xx)); gb.x = xx; gb.st = (volatile LAS unsigned*)(ldsp + TAB_OFF + 512); xcd_barrier(gb, tid); }
        first = false;
        if (ph == 0) { if (EN(13)) {
            for (int m = gw; m < TOK; m += NGW) row_to_bf16(ldp(I_X) + (size_t)m * DM, XB + (size_t)m * DM, (bf16*)nullptr, SS + (size_t)m * 16, lane);
            for (int m = gw; m < MEMROWS; m += NGW) row_to_bf16(ldp(I_MEM) + (size_t)m * DM, MEMB + (size_t)m * DM, (bf16*)nullptr, SSM + (size_t)m * 16, lane);
            constexpr int I_KV = (DM / 64) * (512 / 32);
            for (int it = gw; it < DEPTH * I_KV; it += NGW) { const int l = it / I_KV, r = it - l * I_KV;
                conv_item<4>(ldp(I_XAKV) + (size_t)l * DM * 512, DM, 512, WKV + (size_t)l * 512 * DM, DM, ldp(I_XAMN) + l * DM, scr, r, lane); }
            { GAS unsigned char* og_ = (GAS unsigned char*)a.out; asm volatile("" : "+s"(og_)); convert_layer((unsigned char*)og_ + 64 * MiB, 0, scr, gw, NGW, lane); } }
            continue;
        }
        const int l = (ph - 1) / PH_PER_LAYER, st = (ph - 1) % PH_PER_LAYER;
        GAS float* outg_ = (GAS float*)a.out; asm volatile("" : "+s"(outg_)); float* outp = (float*)outg_;
        unsigned char* wb = (l & 1) ? ws + WS_WB : (unsigned char*)outp + 64 * MiB;
        switch (st) {
        case 0: if (EN(0)) {
            {
                for (size_t i = ((size_t)gw * 64 + lane) * 8; i < (size_t)TOK * DM; i += (size_t)NGW * 64 * 8) {
                    const v4u hwv = *(const v4u*)(XB + i); f32x4 h0, h1; pg8::unpack8(hwv, h0, h1);
                    *(f32x4*)(outp + i) = h0; *(f32x4*)(outp + i + 4) = h1; } }
        } break;
        case 1: case 11: { if (EN(1)) {
            pg8::Gemm g{XB, (const bf16*)(wb + (st == 1 ? WB_GU1 : WB_GU2)), DM, DM}; pg8::OrderStd S; S.init(TOK, 2 * DFF, DM, G, bx);
            pg8::EpiSwiglu E{HB, SS};
            pg8::gemm_phase<pg8::EpiSwiglu, pg8::OrderStd, true, true>(ldsp, g, S, E, tid);
        } } break;
        case 2: case 12: { if (EN(2)) {
            const bool cv = (st == 12) && (l + 1 < DEPTH);
            unsigned char* wbn = ((l + 1) & 1) ? ws + WS_WB : (unsigned char*)outp + 64 * MiB;
            if (st == 12 && l == DEPTH - 1) { pg8::Gemm g{HB, (const bf16*)(wb + WB_D2), DFF, DFF}; pg8::OrderStd S; S.init(TOK, DM, DFF, G, bx);
              pg8::EpiResidF32 E{XB, outp, 0.5f};
              pg8::gemm_phase<pg8::EpiResidF32, pg8::OrderStd, true, true>(ldsp, g, S, E, tid); }
            else { pg8::Gemm g{HB, (const bf16*)(wb + (st == 2 ? WB_D1 : WB_D2)), DFF, DFF}; pg8::OrderStd S; S.init(TOK, DM, DFF, G, bx);
              pg8::EpiResid E{XB, (bf16*)(ws + WS_XL), SS, 0.5f};
              pg8::gemm_phase<pg8::EpiResid, pg8::OrderStd, true, true>(ldsp, g, S, E, tid); }
            if (cv) { __syncthreads(); convert_layer(wbn, l + 1, scr, gw, NGW, lane); __syncthreads(); }
        } } break;
        case 3: { if (EN(3)) {
            pg8::Gemm g{XB, (const bf16*)(wb + WB_IN), DM, DM}; pg8::OrderStd S; S.init(TOK, INCOLS, DM, G, bx);
            pg8::EpiWin E{SS, ZQ, ZK, ZV, ZP, ZC, GT, ldp(I_DAQ) + l * 64, ldp(I_DAK) + l * 64, ldp(I_BG) + l * 3072};
            pg8::gemm_phase<pg8::EpiWin, pg8::OrderStd, true, true>(ldsp, g, S, E, tid);
        } } break;
        case 4: { if (EN(4)) {
            for (int it = vcu; it < 2048; it += G) {
                const int i = it >> 8, v = it & 255, bh = v >> 1, b = bh >> 4, hd = bh & 15, hc = hd >> 1, half = hd & 1, h = hd >> 2;
                const int aa = (v & 1) * 4 + (i >> 1), qb = (i & 1) ? 15 - aa : aa;
                const size_t r0 = (size_t)b * SEQ, rq = r0 + (size_t)qb * 256;
                attn_body::attn_unit<8, true>((const attn_body::bf16*)ZQ + rq * 512 + hc * 64, (const attn_body::bf16*)ZK + r0 * 512 + hc * 64, (const attn_body::bf16*)ZV + r0 * 512 + h * 128 + half * 64,
                                              (attn_body::bf16*)outp + rq * 1024 + hc * 128 + half * 64, 512, 512, 512, 1024, 4 * qb + 4, (char*)lds, tid);
            }
        } } break;
        case 5: { if (EN(5)) {
            const float lam_init = 0.8f - 0.6f * __expf(-0.3f * (float)l);
            LAS float* dwl = (LAS float*)ldsp;
            for (int i = tid; i < 31 * 256; i += NWAVES * 64) dwl[i] = ldp(I_CDW)[(size_t)l * 31 * 256 + i];
            __syncthreads();
            conv_rows(ZC, OABC, dwl, ldp(I_CDB) + l * 256, ldp(I_CLG) + l * 256, ldp(I_CLB) + l * 256, gw, NGW, lane);
            pool_rows(ZP, OABC, gw, NGW, lane);
            diff_rows((const bf16*)outp, OABC, ldp(I_LAM) + l * 256, ldp(I_SUBLN) + l * 128, lam_init, gw, NGW, lane);
            __syncthreads();
        } } break;
        case 6: { if (EN(6)) {
            pg8::Gemm g{OABC, (const bf16*)(wb + WB_PABC), DM, DM}; pg8::OrderSeg3 S; S.init(TOK, DM, G, bx);
            pg8::EpiMerged E{GT, MG, ldp(I_BG) + l * 3072};
            pg8::gemm_phase<pg8::EpiMerged, pg8::OrderSeg3, true, true>(ldsp, g, S, E, tid);
        } } break;
        case 7: { if (EN(7)) {
            pg8::Gemm g{MG, (const bf16*)(wb + WB_OUT), DM, DM}; pg8::OrderStd S; S.init(TOK, DM, DM, G, bx);
            pg8::EpiResid E{XB, (bf16*)(ws + WS_XL), SS, 1.0f};
            pg8::gemm_phase<pg8::EpiResid, pg8::OrderStd, true, true>(ldsp, g, S, E, tid);
        } } break;
        case 8: { if (EN(8)) {
            { pg8::Gemm g{XB, (const bf16*)(wb + WB_XQ), DM, DM}; pg8::OrderStd S; S.init(TOK, 256, DM, G, bx);
              pg8::EpiXq E{SS, QX, ldp(I_XAQN) + l * 64};
              pg8::gemm_phase<pg8::EpiXq, pg8::OrderStd, true, true>(ldsp, g, S, E, tid); }
            if (l == 0) { pg8::Gemm g{MEMB, WKV, DM, DM}; pg8::OrderStd S; S.init(MEMROWS, DEPTH * 512, DM, G, (bx + G / 2) % G);
              pg8::EpiMemKV E{SSM, KX, VX, ldp(I_XAKN)};
              pg8::gemm_phase<pg8::EpiMemKV, pg8::OrderStd, true, true>(ldsp, g, S, E, tid); }
        } } break;
        case 9: { if (EN(9)) {
            for (int it = vcu; it < 512; it += G) {
                const int i = it >> 8, v = it & 255, u = v * 2 + i, b = u >> 6, h = (u >> 4) & 3, qb = u & 15;
                const size_t rq = (size_t)b * SEQ + (size_t)qb * 256, rk = (size_t)l * MEMROWS + (size_t)b * NMEM;
                attn_body::attn_unit<8, false>((const attn_body::bf16*)QX + rq * 256 + h * 64, (const attn_body::bf16*)KX + rk * 256 + h * 64, (const attn_body::bf16*)VX + rk * 256 + h * 64,
                                               (attn_body::bf16*)OX + rq * 256 + h * 64, 256, 256, 256, 256, 4, (char*)lds, tid);
            }
        } } break;
        case 10: { if (EN(10)) {
            pg8::Gemm g{OX, (const bf16*)(wb + WB_XO), 256, 256}; pg8::OrderStd S; S.init(TOK, DM, 256, G, bx);
            pg8::EpiResid E{XB, (bf16*)(ws + WS_XL), SS, 1.0f};
            pg8::gemm_phase<pg8::EpiResid, pg8::OrderStd, true, true>(ldsp, g, S, E, tid);
        } } break;
        }
    }
}


#if MK_N_LAUNCHES == 1
__global__ void __launch_bounds__(NWAVES * 64, 2) mk_fwd(Args a) { mk_body<0xFFFFFFFFu>(a); }
#else
#define MK_KERN(name, mask) __global__ void __launch_bounds__(NWAVES * 64, 2) name(Args a) { mk_body<mask>(a); }
MK_KERN(mk_k_pro, 0x2001u)
MK_KERN(mk_k_up, 0x0002u)
MK_KERN(mk_k_down, 0x0004u)
MK_KERN(mk_k_win, 0x0008u)
MK_KERN(mk_k_attn, 0x0010u)
MK_KERN(mk_k_elem, 0x0020u)
MK_KERN(mk_k_merged, 0x0040u)
MK_KERN(mk_k_wout, 0x0080u)
MK_KERN(mk_k_xq, 0x0100u)
MK_KERN(mk_k_xattn, 0x0200u)
MK_KERN(mk_k_xo, 0x0400u)
#endif
extern "C" void kernel_launch(void* const* d_in, const int* in_sizes, int n_in, void* d_out, int out_size, void* d_ws, size_t ws_size, hipStream_t stream) {
    static int grid = 0;
    if (grid == 0) {
        if (n_in != 32 || in_sizes[0] != TOK * DM || out_size != TOK * DM || ws_size < WS_END) { fprintf(stderr, "kernel_launch: unexpected shapes (n_in %d, in0 %d, out %d, ws %zu < %zu)\n", n_in, n_in > 0 ? in_sizes[0] : -1, out_size, ws_size, (size_t)WS_END); grid = -1; return; }
        int dev = 0, cus = 0, per_cu = 0;
        (void)hipGetDevice(&dev); (void)hipDeviceGetAttribute(&cus, hipDeviceAttributeMultiprocessorCount, dev);
#if MK_N_LAUNCHES == 1
        if (hipFuncSetAttribute((const void*)mk_fwd, hipFuncAttributeMaxDynamicSharedMemorySize, LDS_TOTAL) != hipSuccess) { fprintf(stderr, "kernel_launch: hipFuncSetAttribute failed\n"); grid = -1; return; }
        (void)hipOccupancyMaxActiveBlocksPerMultiprocessor(&per_cu, (const void*)mk_fwd, NWAVES * 64, LDS_TOTAL);
#else
        { const void* ks[] = {(const void*)mk_k_pro, (const void*)mk_k_up, (const void*)mk_k_down, (const void*)mk_k_win, (const void*)mk_k_attn, (const void*)mk_k_elem, (const void*)mk_k_merged, (const void*)mk_k_wout, (const void*)mk_k_xq, (const void*)mk_k_xattn, (const void*)mk_k_xo};
          for (int i = 0; i < 11; ++i) if (hipFuncSetAttribute(ks[i], hipFuncAttributeMaxDynamicSharedMemorySize, LDS_TOTAL) != hipSuccess) { fprintf(stderr, "kernel_launch: hipFuncSetAttribute failed\n"); grid = -1; return; } }
        per_cu = 1;
#endif
        (void)hipGetLastError();
        if (per_cu < 1) per_cu = 1;
        grid = cus * per_cu;
        if (grid != 256) fprintf(stderr, "kernel_launch: note: grid %d (cus %d x %d)\n", grid, cus, per_cu);
    }
    if (grid < 0) return;
    Args a{};
    for (int i = 0; i < 32; ++i) a.in[i] = (const float*)d_in[i];
    a.out = (float*)d_out; a.ws = (unsigned char*)d_ws;
#if MK_N_LAUNCHES == 1
    if (hipMemsetAsync(d_ws, 0, 65536, stream) != hipSuccess) { fprintf(stderr, "kernel_launch: memset failed\n"); return; }
    a.ph_lo = 0; a.ph_hi = NPHASE - 1;
    void* args[] = {&a};
    hipError_t e = hipLaunchCooperativeKernel((const void*)mk_fwd, dim3(grid), dim3(NWAVES * 64), args, LDS_TOTAL, stream);
    if (e != hipSuccess) fprintf(stderr, "cooperative launch failed: %s (grid %d)\n", hipGetErrorString(e), grid);
#else
    for (int ph = 0; ph < NPHASE; ++ph) {
        if (ph == 1) continue;
        a.ph_lo = ph; a.ph_hi = ph + 1;
        const int st = ph == 0 ? -1 : (ph - 1) % PH_PER_LAYER;
        void (*k)(Args) = mk_k_pro;
        switch (st) { case 1: case 11: k = mk_k_up; break; case 2: case 12: k = mk_k_down; break; case 3: k = mk_k_win; break; case 4: k = mk_k_attn; break; case 5: k = mk_k_elem; break;
                      case 6: k = mk_k_merged; break; case 7: k = mk_k_wout; break; case 8: k = mk_k_xq; break; case 9: k = mk_k_xattn; break; case 10: k = mk_k_xo; break; default: break; }
        hipLaunchKernelGGL(k, dim3(grid), dim3(NWAVES * 64), LDS_TOTAL, stream, a);
    }
#endif
}
```
